# Optimizing an MI355X kernel written in HIP

```python
import jax, jax.numpy as jnp
from jax import lax
import numpy as np

D_MODEL = 1024
BATCH = 16
SEQ = 2048
DEPTH = 1

GLA_HEADS = 4
GLA_DK = 128
GLA_DV = 256
GLA_GATE_RANK = 16
GLA_GATE_NORM = 16.0
GLA_CHUNK = 64
SWA_HEADS = 16
SWA_KV_HEADS = 4
SWA_HEAD_DIM = 64
SWA_WINDOW = 128
SWA_BLOCK = 128
ROPE_THETA = 500000.0
ROPE_DIM = SWA_HEAD_DIM // 4
PEER_HEADS = 8
PEER_NKEYS = 128
PEER_EXPERTS = PEER_NKEYS * PEER_NKEYS
PEER_QDIM = 256
PEER_TOPK = 16
PEER_TOKEN_BLOCK = 128
NORM_EPS = 1e-6

GLA_KW = GLA_HEADS * GLA_DK
GLA_VW = GLA_HEADS * GLA_DV
SWA_QW = SWA_HEADS * SWA_HEAD_DIM
SWA_KVW = SWA_KV_HEADS * SWA_HEAD_DIM
IN_SPLITS = (GLA_KW, GLA_KW, GLA_VW, GLA_VW, GLA_GATE_RANK, SWA_QW, SWA_KVW, SWA_KVW, D_MODEL, D_MODEL)
IN_WIDTH = sum(IN_SPLITS)
IN_SPLIT_POINTS = tuple(int(v) for v in np.cumsum(IN_SPLITS)[:-1])

kernel_name = 'hybrid_gla_swa_sink_peer'


def rmsnorm(x, g):
    xf = x.astype(jnp.float32)
    y = xf * lax.rsqrt(jnp.mean(xf * xf, axis=-1, keepdims=True) + NORM_EPS)
    return (y * g.astype(jnp.float32)).astype(x.dtype)


def rope_tables(seqlen):
    pos = jnp.arange(seqlen, dtype=jnp.float32)
    inv_freq = ROPE_THETA ** (-jnp.arange(0, ROPE_DIM, 2, dtype=jnp.float32) / ROPE_DIM)
    ang = pos[:, None] * inv_freq[None, :]
    return jnp.cos(ang), jnp.sin(ang)


def partial_rope(x, cos, sin):
    half = ROPE_DIM // 2
    xf = x.astype(jnp.float32)
    x1, x2, rest = xf[..., :half], xf[..., half:ROPE_DIM], xf[..., ROPE_DIM:]
    c, s = cos[:, None, :], sin[:, None, :]
    return jnp.concatenate([x1 * c - x2 * s, x2 * c + x1 * s, rest], axis=-1).astype(x.dtype)


def gla_chunked(q, k, v, log_a):
    bsz, seqlen, nh, dk = q.shape
    dv = v.shape[-1]
    c = GLA_CHUNK
    n = seqlen // c

    def to_chunks(t):
        return t.astype(jnp.float32).reshape(bsz, n, c, nh, t.shape[-1]).transpose(0, 3, 1, 2, 4)

    qc = to_chunks(q) * (dk ** -0.5)
    kc, vc, ac = to_chunks(k), to_chunks(v), to_chunks(log_a)
    b = jnp.cumsum(ac, axis=3)
    b_ref = b[:, :, :, c // 2:c // 2 + 1]
    b_last = b[:, :, :, -1:]
    causal = jnp.tril(jnp.ones((c, c), dtype=bool))
    att = jnp.einsum('bhntd,bhnsd->bhnts', qc * jnp.exp(b - b_ref), kc * jnp.exp(b_ref - b))
    att = jnp.where(causal, att, 0.0)
    o_intra = jnp.einsum('bhnts,bhnse->bhnte', att, vc)
    q_inter = qc * jnp.exp(b)
    k_end = kc * jnp.exp(b_last - b)
    decay_end = jnp.exp(b_last[:, :, :, 0])

    def step(state, xs):
        qi, ki, vi, di = xs
        out = jnp.einsum('bhtd,bhde->bhte', qi, state)
        state = di[..., None] * state + jnp.einsum('bhsd,bhse->bhde', ki, vi)
        return state, out

    state0 = jnp.zeros((bsz, nh, dk, dv), jnp.float32)
    xs = (jnp.moveaxis(q_inter, 2, 0), jnp.moveaxis(k_end, 2, 0), jnp.moveaxis(vc, 2, 0), jnp.moveaxis(decay_end, 2, 0))
    _, o_inter = lax.scan(step, state0, xs)
    o = o_intra + jnp.moveaxis(o_inter, 0, 2)
    return o.transpose(0, 2, 3, 1, 4).reshape(bsz, seqlen, nh, dv)


def swa_sink_attention(q, k, v, sinks):
    bsz, seqlen, nh, hd = q.shape
    kvh = k.shape[2]
    grp = nh // kvh
    L = SWA_BLOCK
    n = seqlen // L
    qb = q.reshape(bsz, n, L, kvh, grp, hd)
    kb = k.reshape(bsz, n, L, kvh, hd)
    vb = v.reshape(bsz, n, L, kvh, hd)
    kk = jnp.concatenate([jnp.concatenate([jnp.zeros_like(kb[:, :1]), kb[:, :-1]], axis=1), kb], axis=2)
    vv = jnp.concatenate([jnp.concatenate([jnp.zeros_like(vb[:, :1]), vb[:, :-1]], axis=1), vb], axis=2)
    s = jnp.einsum('bnqhgd,bnkhd->bnhgqk', qb, kk).astype(jnp.float32) * (hd ** -0.5)
    qpos = jnp.arange(L)[:, None] + L
    kpos = jnp.arange(2 * L)[None, :]
    rel = qpos - kpos
    band = (rel >= 0) & (rel < SWA_WINDOW)
    valid = band[None] & ((jnp.arange(n)[:, None, None] > 0) | (kpos[None] >= L))
    s = jnp.where(valid[None, :, None, None], s, -jnp.inf)
    sink = sinks.astype(jnp.float32).reshape(kvh, grp)[None, None, :, :, None, None]
    m = jnp.maximum(jnp.max(s, axis=-1, keepdims=True), sink)
    p = jnp.exp(s - m)
    denom = jnp.sum(p, axis=-1, keepdims=True) + jnp.exp(sink - m)
    o = jnp.einsum('bnhgqk,bnkhd->bnqhgd', (p / denom).astype(v.dtype), vv)
    return o.reshape(bsz, seqlen, nh, hd)


def peer_layer(xn, w_pq, sub_keys, expert_u, expert_v):
    bsz, seqlen, d = xn.shape
    t = bsz * seqlen
    xt = xn.reshape(t, d)
    qp = (xt @ w_pq).reshape(t, PEER_HEADS, 2, PEER_QDIM // 2)
    scores = jnp.einsum('thpd,hpkd->thpk', qp, sub_keys).astype(jnp.float32)
    s_top, i_top = lax.top_k(scores, PEER_TOPK)
    cand = (s_top[:, :, 0, :, None] + s_top[:, :, 1, None, :]).reshape(t, PEER_HEADS, PEER_TOPK * PEER_TOPK)
    cand_idx = (i_top[:, :, 0, :, None] * PEER_NKEYS + i_top[:, :, 1, None, :]).reshape(t, PEER_HEADS, PEER_TOPK * PEER_TOPK)
    best, pos = lax.top_k(cand, PEER_TOPK)
    idx = jnp.take_along_axis(cand_idx, pos, axis=-1)
    gate = jax.nn.softmax(best, axis=-1).astype(xn.dtype)
    hk = PEER_HEADS * PEER_TOPK
    nblk = t // PEER_TOKEN_BLOCK

    def expert_block(args):
        xb, ib, gb = args
        u = expert_u[ib]
        h = jax.nn.gelu(jnp.einsum('lkd,ld->lk', u, xb), approximate=False)
        return jnp.einsum('lk,lkd->ld', gb * h, expert_v[ib])

    out = lax.map(expert_block, (xt.reshape(nblk, PEER_TOKEN_BLOCK, d),
                                 idx.reshape(nblk, PEER_TOKEN_BLOCK, hk),
                                 gate.reshape(nblk, PEER_TOKEN_BLOCK, hk)))
    return out.reshape(bsz, seqlen, d)


def setup_inputs(seed: int = 0) -> dict:
    key = jax.random.key(seed)
    ks = jax.random.split(key, 17)
    f32 = jnp.float32
    nrm = lambda k, shape, scale: jax.random.normal(k, shape, f32) * scale
    return {
        'x': nrm(ks[0], (BATCH, SEQ, D_MODEL), 1.0),
        'norm_mix_g': 1.0 + nrm(ks[1], (DEPTH, D_MODEL), 0.02),
        'w_in': nrm(ks[2], (DEPTH, D_MODEL, IN_WIDTH), D_MODEL ** -0.5),
        'w_gk2': nrm(ks[3], (DEPTH, GLA_GATE_RANK, GLA_KW), GLA_GATE_RANK ** -0.5),
        'b_gk': nrm(ks[4], (DEPTH, GLA_KW), 0.1),
        'gla_norm_g': 1.0 + nrm(ks[5], (DEPTH, GLA_DV), 0.02),
        'q_norm_g': 1.0 + nrm(ks[6], (DEPTH, SWA_HEAD_DIM), 0.02),
        'k_norm_g': 1.0 + nrm(ks[7], (DEPTH, SWA_HEAD_DIM), 0.02),
        'attn_sinks': nrm(ks[8], (DEPTH, SWA_HEADS), 0.1),
        'w_branch_a': nrm(ks[9], (DEPTH, GLA_VW, D_MODEL), GLA_VW ** -0.5),
        'w_branch_b': nrm(ks[10], (DEPTH, SWA_QW, D_MODEL), SWA_QW ** -0.5),
        'w_out': nrm(ks[11], (DEPTH, D_MODEL, D_MODEL), D_MODEL ** -0.5),
        'norm_ffn_g': 1.0 + nrm(ks[12], (DEPTH, D_MODEL), 0.02),
        'w_peer_q': nrm(ks[13], (DEPTH, D_MODEL, PEER_HEADS * PEER_QDIM), D_MODEL ** -0.5),
        'peer_sub_keys': nrm(ks[14], (DEPTH, PEER_HEADS, 2, PEER_NKEYS, PEER_QDIM // 2), (PEER_QDIM // 2) ** -0.5),
        'peer_u': nrm(ks[15], (DEPTH, PEER_EXPERTS, D_MODEL), D_MODEL ** -0.5),
        'peer_v': nrm(ks[16], (DEPTH, PEER_EXPERTS, D_MODEL), D_MODEL ** -0.5),
    }


def reference(x, norm_mix_g, w_in, w_gk2, b_gk, gla_norm_g, q_norm_g, k_norm_g, attn_sinks,
              w_branch_a, w_branch_b, w_out, norm_ffn_g, w_peer_q, peer_sub_keys, peer_u, peer_v):
    bsz, seqlen, d = x.shape
    cos, sin = rope_tables(seqlen)
    for l in range(DEPTH):
        h = rmsnorm(x, norm_mix_g[l])
        proj = h @ w_in[l]
        gq, gk, gv, gr, glr, sq, sk, sv, gate_a, gate_b = jnp.split(proj, IN_SPLIT_POINTS, axis=-1)
        log_a = jax.nn.log_sigmoid((glr @ w_gk2[l] + b_gk[l]).astype(jnp.float32)) / GLA_GATE_NORM
        o_a = gla_chunked(gq.reshape(bsz, seqlen, GLA_HEADS, GLA_DK),
                          gk.reshape(bsz, seqlen, GLA_HEADS, GLA_DK),
                          gv.reshape(bsz, seqlen, GLA_HEADS, GLA_DV),
                          log_a.reshape(bsz, seqlen, GLA_HEADS, GLA_DK))
        o_a = rmsnorm(o_a, gla_norm_g[l]).astype(x.dtype) * jax.nn.silu(gr.reshape(bsz, seqlen, GLA_HEADS, GLA_DV))
        y_a = o_a.reshape(bsz, seqlen, GLA_VW) @ w_branch_a[l]
        q = partial_rope(rmsnorm(sq.reshape(bsz, seqlen, SWA_HEADS, SWA_HEAD_DIM), q_norm_g[l]), cos, sin)
        k = partial_rope(rmsnorm(sk.reshape(bsz, seqlen, SWA_KV_HEADS, SWA_HEAD_DIM), k_norm_g[l]), cos, sin)
        o_b = swa_sink_attention(q, k, sv.reshape(bsz, seqlen, SWA_KV_HEADS, SWA_HEAD_DIM), attn_sinks[l])
        y_b = o_b.reshape(bsz, seqlen, SWA_QW) @ w_branch_b[l]
        merged = jax.nn.sigmoid(gate_a) * y_a + jax.nn.sigmoid(gate_b) * y_b
        x = x + merged @ w_out[l]
        x = x + peer_layer(rmsnorm(x, norm_ffn_g[l]), w_peer_q[l], peer_sub_keys[l], peer_u[l], peer_v[l])
    return x
```

```cpp
#define SLOW_TOPK 1
#include <hip/hip_runtime.h>
#include <cstdio>
#include <cstdint>
namespace pg8 {
#define PG8_LAS __attribute__((address_space(3)))
typedef unsigned short bf16_t;
typedef short bf16x8 __attribute__((ext_vector_type(8)));
typedef float f32x4 __attribute__((ext_vector_type(4)));
typedef unsigned u32x4 __attribute__((ext_vector_type(4)));
constexpr int BM = 256, BK = 64, HALF = 128, HTB = HALF * BK * 2  , STAGE_BYTES = 8 * HTB, NXCD = 8, WGM = 8;

__host__ __device__ __forceinline__ int lds_byte(int r, int c) { const int st = (r >> 4) * 2 + (c >> 5), rr = r & 15, cc = c & 31, ob = rr * 64 + cc * 2; return st * 1024 + (ob ^ (((ob >> 9) & 1) << 5)); }
__host__ __device__ __forceinline__ void stage_rc(int b, int& R, int& C) { const int st = b / 1024, sb = b % 1024, swz = sb ^ (((sb >> 9) & 1) << 5); R = (st >> 1) * 16 + swz / 64; C = (st & 1) * 32 + (swz % 64) / 2; }
__host__ __device__ __forceinline__ int perm32(int rho) { const int n = rho >> 4, i = rho & 15; return 8 * (i >> 2) + 4 * n + (i & 3); }

struct Unit { int pm, pn; };
struct Gemm { const bf16_t* A; const bf16_t* Bt; int M, N, K; };

struct StaticOrder {
    int nM, nN, nwg, G, c;
    __host__ __device__ void init(int M, int N, int G_, int c_) { nM = M / BM; nN = N / BM; nwg = nM * nN; G = G_; c = c_; }
    __host__ __device__ bool next(int i, Unit& u) const {
        const long L = (long)i * G + c; if (L >= nwg) return false;
        int wgid = (int)L; { const int q = nwg / NXCD, r = nwg % NXCD, xcd = wgid % NXCD, off = wgid / NXCD; wgid = (xcd < r ? xcd * (q + 1) : r * (q + 1) + (xcd - r) * q) + off; }
        const int nig = WGM * nN, gid = wgid / nig, fm = gid * WGM, gsz = (nM - fm) < WGM ? (nM - fm) : WGM;
        u.pm = fm + ((wgid % nig) % gsz); u.pn = (wgid % nig) / gsz; return true;
    }
    __device__ __forceinline__ void a_ready(const Unit&) const {}
    __device__ __forceinline__ void done(const Unit&) const {}
};
__device__ __forceinline__ unsigned cvt_pk_bf16(float lo, float hi) { unsigned r; asm volatile("v_cvt_pk_bf16_f32 %0, %1, %2" : "=v"(r) : "v"(lo), "v"(hi)); return r; }
typedef float f32x2 __attribute__((ext_vector_type(2)));
template <class Epi, class Sched, bool ALIGN_EPI = false, bool SP2 = false>
__device__ __forceinline__ void gemm_phase(PG8_LAS unsigned char* lds, const Gemm g, const Sched& S, const Epi& E) {
    const int tid = threadIdx.x, wid = __builtin_amdgcn_readfirstlane(tid >> 6), lane = tid & 63, wr = wid >> 2, wc = wid & 3, fr = lane & 15, fq = lane >> 4;
    const int K = g.K, nt = K / BK;
    unsigned voffA[2], voffB[2];
#pragma unroll
    for (int i = 0; i < 2; ++i) { int R, C; stage_rc(tid * 16 + i * 8192, R, C); const int Rb = Epi::PERM ? ((R & ~31) + perm32(R & 31)) : R;
        voffA[i] = (unsigned)(R * K + C) * 2u; voffB[i] = (unsigned)(Rb * K + C) * 2u; }
    const size_t kstep = (size_t)(BK * 2);
    const size_t hstep = (size_t)HALF * K * 2;
    const size_t tstep = 2 * hstep;
    const unsigned ldsw = (unsigned)wid * 1024u;
    const int aoff = lds_byte(wr * 64 + fr, fq * 8), boff = lds_byte(wc * 32 + fr, fq * 8);
#define PG8_SA(b, h) (((b) * 2 + (h)) * HTB)
#define PG8_SB(b, h) ((4 + (b) * 2 + (h)) * HTB)
#define PG8_STAGE(bufoff, gbase, voff) do { _Pragma("unroll") for (int _i = 0; _i < 2; ++_i) \
        __builtin_amdgcn_global_load_lds((const unsigned*)((const char*)(gbase) + (voff)[_i]), (PG8_LAS unsigned*)(lds + (bufoff) + ldsw + _i * 8192), 16, 0, 0); } while (0)
#define PG8_LDA(dst, b, h) do { _Pragma("unroll") for (int m = 0; m < 4; ++m) _Pragma("unroll") for (int k = 0; k < 2; ++k) dst[m][k] = *(const PG8_LAS bf16x8*)(lds + PG8_SA(b, h) + aoff + m * 2048 + k * 1024); } while (0)
#define PG8_LDB(dst, b, h) do { _Pragma("unroll") for (int n = 0; n < 2; ++n) _Pragma("unroll") for (int k = 0; k < 2; ++k) dst[n][k] = *(const PG8_LAS bf16x8*)(lds + PG8_SB(b, h) + boff + n * 2048 + k * 1024); } while (0)
#define PG8_MMA(ai, bj, At, Bt) do { __builtin_amdgcn_s_setprio(1); _Pragma("unroll") for (int m = 0; m < 4; ++m) _Pragma("unroll") for (int n = 0; n < 2; ++n) _Pragma("unroll") for (int k = 0; k < 2; ++k) \
        acc[ai][bj][m][n] = __builtin_amdgcn_mfma_f32_16x16x32_bf16(Bt[n][k], At[m][k], acc[ai][bj][m][n], 0, 0, 0); __builtin_amdgcn_s_setprio(0); } while (0)
#define PG8_WAIT_V(n) asm volatile("s_waitcnt vmcnt(" #n ")" ::: "memory")
#define PG8_WAIT_L(n) asm volatile("s_waitcnt lgkmcnt(" #n ")" ::: "memory")
#define PG8_BAR __builtin_amdgcn_s_barrier()
#define PG8_SCHED __builtin_amdgcn_sched_barrier(0)
    Unit cur, nxt; int ui = 0;
    if (!S.next(0, cur)) return;
    f32x4 acc[2][2][4][2];
#pragma unroll
    for (int a = 0; a < 2; ++a)
#pragma unroll
        for (int b = 0; b < 2; ++b)
#pragma unroll
            for (int m = 0; m < 4; ++m)
#pragma unroll
                for (int n = 0; n < 2; ++n) acc[a][b][m][n] = (f32x4){0.f, 0.f, 0.f, 0.f};
    bf16x8 At[4][2], B0[2][2], B1[2][2];
    const char* cA = (const char*)g.A + (size_t)cur.pm * tstep; const char* cB = (const char*)g.Bt + (size_t)cur.pn * tstep;
    S.a_ready(cur);
    if constexpr (SP2) {
        PG8_STAGE(PG8_SB(0, 0), cB, voffB); PG8_STAGE(PG8_SB(0, 1), cB + hstep, voffB); PG8_STAGE(PG8_SA(0, 0), cA, voffA); PG8_STAGE(PG8_SA(0, 1), cA + hstep, voffA);
        if (wr == 1) PG8_BAR;
        PG8_WAIT_V(2); PG8_BAR;
        PG8_STAGE(PG8_SB(1, 0), cB + kstep, voffB); PG8_STAGE(PG8_SA(1, 0), cA + kstep, voffA); PG8_STAGE(PG8_SB(1, 1), cB + hstep + kstep, voffB);
        PG8_WAIT_V(6); PG8_BAR;
    } else {
        PG8_STAGE(PG8_SB(0, 0), cB, voffB); PG8_STAGE(PG8_SA(0, 0), cA, voffA); PG8_STAGE(PG8_SB(0, 1), cB + hstep, voffB); PG8_STAGE(PG8_SA(0, 1), cA + hstep, voffA);
        if (wr == 1) PG8_BAR;
        PG8_WAIT_V(4); PG8_BAR;
        PG8_STAGE(PG8_SB(1, 0), cB + kstep, voffB); PG8_STAGE(PG8_SA(1, 0), cA + kstep, voffA); PG8_STAGE(PG8_SB(1, 1), cB + hstep + kstep, voffB);
        PG8_WAIT_V(6); PG8_BAR;
    }
    for (;;) {
        const bool has_next = S.next(ui + 1, nxt);
        const char* nA = has_next ? (const char*)g.A + (size_t)nxt.pm * tstep : cA; const char* nB = has_next ? (const char*)g.Bt + (size_t)nxt.pn * tstep : cB;
        for (int t = 0; t < nt; t += 2) {
            const bool last = (t == nt - 2);
            const char* a1 = cA + (size_t)(t + 1) * kstep;
            const char* a2 = last ? nA : cA + (size_t)(t + 2) * kstep; const char* b2 = last ? nB : cB + (size_t)(t + 2) * kstep;
            const char* a3 = a2 + kstep; const char* b3 = b2 + kstep;
            if (last && has_next) S.a_ready(nxt);
            if constexpr (SP2) {
            PG8_LDB(B0, 0, 0); PG8_LDB(B1, 0, 1); PG8_SCHED; PG8_LDA(At, 0, 0); PG8_STAGE(PG8_SA(1, 1), a1 + hstep, voffA);
            PG8_WAIT_V(8); PG8_WAIT_L(0); PG8_BAR; PG8_MMA(0, 0, At, B0); PG8_MMA(0, 1, At, B1); PG8_BAR; PG8_SCHED;
            PG8_LDA(At, 0, 1); PG8_STAGE(PG8_SB(0, 0), b2, voffB); PG8_STAGE(PG8_SB(0, 1), b2 + hstep, voffB); PG8_STAGE(PG8_SA(0, 0), a2, voffA);
            PG8_WAIT_V(8); PG8_WAIT_L(0); PG8_BAR; PG8_MMA(1, 0, At, B0); PG8_MMA(1, 1, At, B1); PG8_BAR; PG8_SCHED;
            PG8_LDB(B0, 1, 0); PG8_LDB(B1, 1, 1); PG8_SCHED; PG8_LDA(At, 1, 0); PG8_STAGE(PG8_SA(0, 1), a2 + hstep, voffA);
            PG8_WAIT_V(8); PG8_WAIT_L(0); PG8_BAR; PG8_MMA(0, 0, At, B0); PG8_MMA(0, 1, At, B1); PG8_BAR; PG8_SCHED;
            PG8_LDA(At, 1, 1); PG8_STAGE(PG8_SB(1, 0), b3, voffB); PG8_STAGE(PG8_SB(1, 1), b3 + hstep, voffB); PG8_STAGE(PG8_SA(1, 0), a3, voffA);
            PG8_WAIT_V(8); PG8_WAIT_L(0); PG8_BAR; PG8_MMA(1, 0, At, B0); PG8_MMA(1, 1, At, B1); PG8_BAR; PG8_SCHED;
            } else {
            PG8_LDB(B0, 0, 0); PG8_SCHED; PG8_LDA(At, 0, 0); PG8_STAGE(PG8_SA(1, 1), a1 + hstep, voffA);
            PG8_WAIT_L(8); PG8_BAR; PG8_WAIT_L(0); PG8_MMA(0, 0, At, B0); PG8_BAR; PG8_SCHED;
            PG8_LDB(B1, 0, 1); PG8_STAGE(PG8_SB(0, 0), b2, voffB);
            PG8_BAR; PG8_WAIT_L(0); PG8_MMA(0, 1, At, B1); PG8_BAR;
            PG8_LDA(At, 0, 1); PG8_STAGE(PG8_SA(0, 0), a2, voffA);
            PG8_BAR; PG8_WAIT_L(0); PG8_MMA(1, 0, At, B0); PG8_BAR; PG8_SCHED;
            PG8_STAGE(PG8_SB(0, 1), b2 + hstep, voffB);
            PG8_WAIT_V(6); PG8_BAR; PG8_MMA(1, 1, At, B1); PG8_BAR;
            PG8_LDB(B0, 1, 0); PG8_SCHED; PG8_LDA(At, 1, 0); PG8_STAGE(PG8_SA(0, 1), a2 + hstep, voffA);
            PG8_WAIT_L(8); PG8_BAR; PG8_WAIT_L(0); PG8_MMA(0, 0, At, B0); PG8_BAR; PG8_SCHED;
            PG8_LDB(B1, 1, 1); PG8_STAGE(PG8_SB(1, 0), b3, voffB);
            PG8_BAR; PG8_WAIT_L(0); PG8_MMA(0, 1, At, B1); PG8_BAR;
            PG8_LDA(At, 1, 1); PG8_STAGE(PG8_SA(1, 0), a3, voffA);
            PG8_BAR; PG8_WAIT_L(0); PG8_MMA(1, 0, At, B0); PG8_BAR; PG8_SCHED;
            PG8_STAGE(PG8_SB(1, 1), b3 + hstep, voffB);
            PG8_WAIT_V(6); PG8_BAR; PG8_MMA(1, 1, At, B1); PG8_BAR;
            }
        }
        if constexpr (ALIGN_EPI) { if (wr == 0) PG8_BAR; }
        if constexpr (!Epi::AFTER_DRAIN) { E(acc, cur, wr, wc, fr, fq); S.done(cur); }
        if (!has_next) break;
#pragma unroll
        for (int a = 0; a < 2; ++a)
#pragma unroll
            for (int b = 0; b < 2; ++b)
#pragma unroll
                for (int m = 0; m < 4; ++m)
#pragma unroll
                    for (int n = 0; n < 2; ++n) acc[a][b][m][n] = (f32x4){0.f, 0.f, 0.f, 0.f};
        cur = nxt; cA = nA; cB = nB; ++ui;
        if constexpr (ALIGN_EPI) { if (wr == 1) PG8_BAR; }
    }
    PG8_WAIT_V(0);
    if constexpr (!ALIGN_EPI) { if (wr == 0) PG8_BAR; }
    PG8_BAR;
    if constexpr (Epi::AFTER_DRAIN) { E.fused(acc, cur, wr, wc, fr, fq, lds, wid, lane); S.done(cur); }
#undef PG8_SA
#undef PG8_SB
#undef PG8_STAGE
#undef PG8_LDA
#undef PG8_LDB
#undef PG8_MMA
#undef PG8_WAIT_V
#undef PG8_WAIT_L
#undef PG8_BAR
#undef PG8_SCHED
}
}
#define GAS __attribute__((address_space(1)))
#define LAS __attribute__((address_space(3)))
typedef unsigned short bf16;
typedef unsigned v4u __attribute__((ext_vector_type(4)));
typedef float f32x4 __attribute__((ext_vector_type(4)));
typedef short bf16x8 __attribute__((ext_vector_type(8)));
typedef GAS unsigned gu32;
typedef GAS unsigned long long gu64;
#define RLX_AGENT __ATOMIC_RELAXED, __HIP_MEMORY_SCOPE_AGENT
#define LDS_WAIT() asm volatile("s_waitcnt lgkmcnt(0)" ::: "memory")
#define VM_WAIT() asm volatile("s_waitcnt vmcnt(0)" ::: "memory")
__device__ __forceinline__ unsigned long long rt() { return __builtin_amdgcn_s_memrealtime(); }
__device__ __forceinline__ unsigned f2bf(float f) { unsigned u = __builtin_bit_cast(unsigned, f); return (u + 0x7fffu + ((u >> 16) & 1u)) >> 16; }
__device__ __forceinline__ unsigned pk2(float lo, float hi) { return f2bf(lo) | (f2bf(hi) << 16); }
#define XB_TMO      128
#define XB_XCNT(j)  (256  + 64 * (j))
#define XB_XSUB(j)  (1280 + 64 * (j))
#define XB_XGEN(j)  (2304 + 64 * (j))
#define XB_TOP      3328
#define XB_TOPGEN   3392
#define XCD_BAR_WORDS 3456
#define XB_SPIN_CAP (1u << 18)

__device__ __forceinline__ unsigned xb_ld(unsigned* p)              { return __hip_atomic_load(p, __ATOMIC_RELAXED, __HIP_MEMORY_SCOPE_AGENT); }
__device__ __forceinline__ unsigned xb_add(unsigned* p, unsigned v) { return __hip_atomic_fetch_add(p, v, __ATOMIC_RELAXED, __HIP_MEMORY_SCOPE_AGENT); }
__device__ __forceinline__ unsigned xb_xcc_id() { return (unsigned)__builtin_amdgcn_s_getreg((3 << 11) | 20) & 0xFu; }
#define XB_SPIN(cond, bar) do { unsigned _sp = 0; while (cond) { __builtin_amdgcn_s_sleep(1); \
    if ((++_sp & 255u) == 0u) { if (xb_ld(&(bar)[XB_TMO])) break; if (_sp > XB_SPIN_CAP) { atomicAdd(&(bar)[XB_TMO], 1u); break; } } } } while (0)

struct XcdBarrier {
    unsigned* bar; unsigned x;
    volatile LAS unsigned* st;
};

__device__ __forceinline__ XcdBarrier xcd_barrier_post(unsigned* bar, volatile LAS unsigned* st) {
    XcdBarrier b; b.bar = bar; b.x = xb_xcc_id(); b.st = st;
    if (threadIdx.x == 0) (void)xb_add(&bar[XB_XCNT(b.x)], 1u);
    return b;
}
__device__ __forceinline__ void xcd_barrier_complete(unsigned* bar, unsigned x, unsigned& nloc, unsigned& nx) {
    const unsigned G = gridDim.x * gridDim.y * gridDim.z;
    unsigned sum, cnt, mine, sp = 0u;
    for (;;) {
        sum = 0u; cnt = 0u; mine = 0u;
#pragma unroll
        for (unsigned j = 0; j < 16; ++j) { const unsigned c = xb_ld(&bar[XB_XCNT(j)]); sum += c; cnt += (c > 0u) ? 1u : 0u; mine = (j == x) ? c : mine; }
        if (sum == G) break;
        __builtin_amdgcn_s_sleep(1);
        if ((++sp & 255u) == 0u) { if (xb_ld(&bar[XB_TMO])) break; if (sp > XB_SPIN_CAP) { atomicAdd(&bar[XB_TMO], 1u); break; } }
    }
    nloc = mine > 0u ? mine : 1u; nx = cnt > 0u ? cnt : 1u;
}

__device__ __forceinline__ void xcd_barrier(const XcdBarrier& b) {
    asm volatile("s_waitcnt vmcnt(0)" ::: "memory");
    __syncthreads();
    if (threadIdx.x == 0) {
        unsigned* bar = b.bar;
        __builtin_amdgcn_s_waitcnt(0);
        unsigned nloc = b.st[0], nx = b.st[1];
        if (nloc == 0u) { xcd_barrier_complete(bar, b.x, nloc, nx); b.st[0] = nloc; b.st[1] = nx; }
        const unsigned old = xb_add(&bar[XB_XSUB(b.x)], 1u);
        const unsigned gen = old / nloc;
        if (old + 1u == (gen + 1u) * nloc) {
            __builtin_amdgcn_fence(__ATOMIC_RELEASE, "agent");
            asm volatile("s_waitcnt vmcnt(0)" ::: "memory");
            const unsigned og = xb_add(&bar[XB_TOP], 1u);
            const unsigned tg = og / nx;
            if (og + 1u == (tg + 1u) * nx) xb_add(&bar[XB_TOPGEN], 1u);
            else XB_SPIN(xb_ld(&bar[XB_TOPGEN]) == tg, bar);
            __builtin_amdgcn_fence(__ATOMIC_ACQUIRE, "agent");
            xb_add(&bar[XB_XGEN(b.x)], 1u);
            asm volatile("s_waitcnt vmcnt(0)" ::: "memory");
        } else {
            XB_SPIN(xb_ld(&bar[XB_XGEN(b.x)]) == gen, bar);
            __builtin_amdgcn_fence(__ATOMIC_ACQUIRE, "agent");
            asm volatile("s_waitcnt vmcnt(0)" ::: "memory");
        }
    }
    __syncthreads();
}
constexpr int NWAVES = 8, NTHR = 512;
constexpr int T = 32768, SEQ = 2048, NBATCH = 16, D = 1024;
constexpr int NPROJ = 6912, INW = 6672;
constexpr float EPS = 1e-6f;
constexpr size_t MiB = 1u << 20;
constexpr size_t WS_CTL = 0, CTL_ZERO_BYTES = 64 * 1024;
constexpr size_t WS_GLR = 1 * MiB, WS_ROPE = 3 * MiB, WS_WIN = 4 * MiB, WS_WA = 18 * MiB, WS_WB = 20 * MiB, WS_WO = 22 * MiB, WS_WPQ = 24 * MiB, WS_SUBK = 28 * MiB;
constexpr size_t WS_H = 32 * MiB, WS_U = 32 * MiB, WS_V = 64 * MiB;
constexpr size_t WS_GQ = 96 * MiB, WS_GK = 128 * MiB, WS_GV = 160 * MiB, WS_GR = 224 * MiB, WS_SQ = 288 * MiB, WS_SK = 352 * MiB, WS_SV = 368 * MiB, WS_GA = 384 * MiB, WS_GB = 448 * MiB;
constexpr size_t WS_YA = 96 * MiB, WS_XN2 = 160 * MiB, WS_QP = 224 * MiB, WS_IDX = 352 * MiB, WS_GATE = 368 * MiB, WS_END = 512 * MiB;
constexpr int CW_BAR = 1024;
constexpr int LDS_BYTES = 163840, MISC_OFF = LDS_BYTES - 256;

typedef unsigned long long u64;
typedef float f32x16 __attribute__((ext_vector_type(16)));
typedef __bf16 bf2_t __attribute__((ext_vector_type(2)));
typedef LAS unsigned char* ldsp;

__device__ __forceinline__ float bf_lo(unsigned u) { return __builtin_bit_cast(float, u << 16); }
__device__ __forceinline__ float bf_hi(unsigned u) { return __builtin_bit_cast(float, u & 0xffff0000u); }
__device__ __forceinline__ float wave_sum(float v) {
#pragma unroll
    for (int o = 1; o < 64; o <<= 1) v += __shfl_xor(v, o);
    return v;
}
__device__ __forceinline__ float sigmoidf_(float x) { return 1.f / (1.f + __expf(-x)); }
__device__ __forceinline__ float logsigmoidf_(float z) { return fminf(z, 0.f) - log1pf(expf(-fabsf(z))); }

struct Frame {
    ldsp lds;
    unsigned char* ws; float* out;
    const float* in[17];
    int tid, lane, wave, vcu, G;
};

__device__ __forceinline__ void transpose_item(const float* W, int ldw, int src_col0, int valid_cols, int K, bf16* WT, int dst_row0, int nblk, LAS float* scr, int item, int lane) {
    const int kb = item / nblk, nb = item % nblk, k0 = 64 * kb, n0 = 32 * nb;
    const int nl = n0 + (lane & 31);
#pragma unroll 8
    for (int i = 0; i < 32; ++i) { const int kk = 2 * i + (lane >> 5); scr[kk * 33 + (lane & 31)] = (nl < valid_cols) ? W[(size_t)(k0 + kk) * ldw + src_col0 + nl] : 0.f; }
    LDS_WAIT(); asm volatile("" ::: "memory");
    const int c = lane & 7;
#pragma unroll
    for (int j = 0; j < 4; ++j) { const int n = (lane >> 3) + 8 * j; const LAS float* s = scr + (8 * c) * 33 + n;
        v4u o; o.x = pk2(s[0 * 33], s[1 * 33]); o.y = pk2(s[2 * 33], s[3 * 33]); o.z = pk2(s[4 * 33], s[5 * 33]); o.w = pk2(s[6 * 33], s[7 * 33]);
        *(GAS v4u*)(WT + (size_t)(dst_row0 + n0 + n) * K + k0 + 8 * c) = o; }
    LDS_WAIT(); asm volatile("" ::: "memory");
}
__device__ __forceinline__ void rms_row_to_bf16(int lane, const float* xrow, const float* g, bf16* orow) {
    const f32x4* xr = (const f32x4*)xrow + lane; const f32x4* gr = (const f32x4*)g + lane;
    f32x4 v[4]; float s = 0.f;
#pragma unroll
    for (int j = 0; j < 4; ++j) { v[j] = xr[64 * j]; s += (v[j].x * v[j].x + v[j].y * v[j].y) + (v[j].z * v[j].z + v[j].w * v[j].w); }
    const float rstd = 1.f / sqrtf(wave_sum(s) * (1.f / D) + EPS);
    u64* o8 = (u64*)orow + lane;
#pragma unroll
    for (int j = 0; j < 4; ++j) { const f32x4 gg = gr[64 * j];
        o8[64 * j] = (u64)pk2(v[j].x * rstd * gg.x, v[j].y * rstd * gg.y) | ((u64)pk2(v[j].z * rstd * gg.z, v[j].w * rstd * gg.w) << 32); }
}
__device__ __forceinline__ void cvt_rows_bf16(const float* src, bf16* dst, size_t n8, size_t gtid, size_t gthreads) {
    for (size_t i = gtid; i < n8; i += gthreads) { const f32x4 a = ((const f32x4*)src)[2 * i], b = ((const f32x4*)src)[2 * i + 1];
        v4u o; o.x = pk2(a.x, a.y); o.y = pk2(a.z, a.w); o.z = pk2(b.x, b.y); o.w = pk2(b.z, b.w); ((v4u*)dst)[i] = o; }
}
__device__ __forceinline__ void p0_prologue(Frame& F) {
    LAS float* scr = (LAS float*)(F.lds + F.wave * 16384);
    const int gw = F.vcu * NWAVES + F.wave, NGW = F.G * NWAVES;
    const float* w_in = F.in[2];
    constexpr int I1 = 16 * 96, I2 = 16 * 112, I3 = 16 * 8, I4 = 16 * 32, I7 = 16 * 64;
    constexpr int NITEMS = I1 + I2 + I3 + 3 * I4 + I7;
    for (int it = gw; it < NITEMS; it += NGW) {
        int r = it;
        if (r < I1) { transpose_item(w_in, INW, 0, 3072, D, (bf16*)(F.ws + WS_WIN), 0, 96, scr, r, F.lane); continue; } r -= I1;
        if (r < I2) { transpose_item(w_in, INW, 3088, 3584, D, (bf16*)(F.ws + WS_WIN), 3072, 112, scr, r, F.lane); continue; } r -= I2;
        if (r < I3) { transpose_item(w_in, INW, 3072, 16, D, (bf16*)(F.ws + WS_WIN), 6656, 8, scr, r, F.lane); continue; } r -= I3;
        if (r < I4) { transpose_item(F.in[9], D, 0, D, D, (bf16*)(F.ws + WS_WA), 0, 32, scr, r, F.lane); continue; } r -= I4;
        if (r < I4) { transpose_item(F.in[10], D, 0, D, D, (bf16*)(F.ws + WS_WB), 0, 32, scr, r, F.lane); continue; } r -= I4;
        if (r < I4) { transpose_item(F.in[11], D, 0, D, D, (bf16*)(F.ws + WS_WO), 0, 32, scr, r, F.lane); continue; } r -= I4;
        transpose_item(F.in[13], 2048, 0, 2048, D, (bf16*)(F.ws + WS_WPQ), 0, 64, scr, r, F.lane);
    }
    for (int m = gw; m < T; m += NGW) rms_row_to_bf16(F.lane, F.in[0] + (size_t)m * D, F.in[1], (bf16*)(F.ws + WS_H) + (size_t)m * D);
    const size_t gtid = (size_t)F.vcu * NTHR + F.tid, gthreads = (size_t)F.G * NTHR;
    cvt_rows_bf16(F.in[14], (bf16*)(F.ws + WS_SUBK), (size_t)(8 * 2 * 128 * 128) / 8, gtid, gthreads);
    if (gtid < (size_t)SEQ * 8) {
        const double invf[8] = {1.0, 0.19392274474868576, 0.03760603093086393, 0.007292664737217109, 0.001414213562373095, 0.0002742481756762073, 5.318295896944988e-05, 1.031338537721246e-05};
        const int pos = (int)(gtid >> 3), j = (int)(gtid & 7);
        double iv = invf[0];
#pragma unroll
        for (int q = 1; q < 8; ++q) iv = (j == q) ? invf[q] : iv;
        const float angf = (float)pos * (float)iv;
        const double rev = (double)angf * 0.15915494309189535;
        const double fr = rev - floor(rev);
        const float f = (float)fr;
        float2 cs; cs.x = __builtin_amdgcn_cosf(f); cs.y = __builtin_amdgcn_sinf(f);
        ((float2*)(F.ws + WS_ROPE))[gtid] = cs;
    }
}
template <int MODE> struct EpiB {
    static constexpr bool PERM = true, AFTER_DRAIN = false;
    unsigned char* ws;
    __device__ __forceinline__ void operator()(const pg8::f32x4 (&acc)[2][2][4][2], const pg8::Unit& u, int wr, int wc, int fr, int fq) const {
        using namespace pg8;
        const int row0 = u.pm * BM + wr * 64 + fr;
        bf16_t* base; int ldc, colt, act = 0; const bf16_t* gate = nullptr;
        if (MODE == 0) {
            const int pn = u.pn;
            if (pn == 26) {
                if (wc == 0 && fq < 2) { float* G = (float*)(ws + WS_GLR);
#pragma unroll
                    for (int ai = 0; ai < 2; ++ai)
#pragma unroll
                        for (int m = 0; m < 4; ++m) { float* rp = G + (size_t)(row0 + ai * HALF + m * 16) * 16 + 8 * fq; *(f32x4*)rp = acc[ai][0][m][0]; *(f32x4*)(rp + 4) = acc[ai][0][m][1]; } }
                return;
            }
            size_t off;
            if (pn < 2) { off = WS_GQ; ldc = 512; colt = pn * 256; }
            else if (pn < 4) { off = WS_GK; ldc = 512; colt = (pn - 2) * 256; }
            else if (pn < 8) { off = WS_GV; ldc = 1024; colt = (pn - 4) * 256; }
            else if (pn < 12) { off = WS_GR; ldc = 1024; colt = (pn - 8) * 256; act = 1; }
            else if (pn < 16) { off = WS_SQ; ldc = 1024; colt = (pn - 12) * 256; }
            else if (pn < 17) { off = WS_SK; ldc = 256; colt = 0; }
            else if (pn < 18) { off = WS_SV; ldc = 256; colt = 0; }
            else if (pn < 22) { off = WS_GA; ldc = 1024; colt = (pn - 18) * 256; act = 2; }
            else { off = WS_GB; ldc = 1024; colt = (pn - 22) * 256; act = 2; }
            base = (bf16_t*)(ws + off);
        } else if (MODE == 1) { base = (bf16_t*)(ws + WS_YA); ldc = 1024; colt = u.pn * BM; gate = (const bf16_t*)(ws + WS_GA); }
        else if (MODE == 2) { base = (bf16_t*)(ws + WS_YA); ldc = 1024; colt = u.pn * BM; gate = (const bf16_t*)(ws + WS_GB); }
        else { base = (bf16_t*)(ws + WS_QP); ldc = 2048; colt = u.pn * BM; }
        const int col0 = colt + wc * 32 + 8 * fq;
#pragma unroll
        for (int ai = 0; ai < 2; ++ai)
#pragma unroll
            for (int m = 0; m < 4; ++m) { const size_t ro = (size_t)(row0 + ai * HALF + m * 16) * ldc + col0;
#pragma unroll
                for (int bj = 0; bj < 2; ++bj) { f32x4 v0 = acc[ai][bj][m][0], v1 = acc[ai][bj][m][1];
                    if (MODE == 0) {
                        if (act == 1) {
#pragma unroll
                            for (int e = 0; e < 4; ++e) { v0[e] = v0[e] * sigmoidf_(v0[e]); v1[e] = v1[e] * sigmoidf_(v1[e]); } }
                        else if (act == 2) {
#pragma unroll
                            for (int e = 0; e < 4; ++e) { v0[e] = sigmoidf_(v0[e]); v1[e] = sigmoidf_(v1[e]); } }
                    }
                    if (MODE == 1 || MODE == 2) {
                        const u32x4 gv = *(const u32x4*)(gate + ro + bj * HALF);
                        v0[0] *= bf_lo(gv.x); v0[1] *= bf_hi(gv.x); v0[2] *= bf_lo(gv.y); v0[3] *= bf_hi(gv.y);
                        v1[0] *= bf_lo(gv.z); v1[1] *= bf_hi(gv.z); v1[2] *= bf_lo(gv.w); v1[3] *= bf_hi(gv.w);
                        if (MODE == 2) { const u32x4 yv = *(const u32x4*)(base + ro + bj * HALF);
                            v0[0] += bf_lo(yv.x); v0[1] += bf_hi(yv.x); v0[2] += bf_lo(yv.y); v0[3] += bf_hi(yv.y);
                            v1[0] += bf_lo(yv.z); v1[1] += bf_hi(yv.z); v1[2] += bf_lo(yv.w); v1[3] += bf_hi(yv.w); }
                    }
                    u32x4 w; w.x = cvt_pk_bf16(v0[0], v0[1]); w.y = cvt_pk_bf16(v0[2], v0[3]); w.z = cvt_pk_bf16(v1[0], v1[1]); w.w = cvt_pk_bf16(v1[2], v1[3]);
                    *(u32x4*)(base + ro + bj * HALF) = w; } }
    }
};
struct EpiX1 {
    static constexpr bool PERM = false, AFTER_DRAIN = false;
    const float* x; float* out;
    __device__ __forceinline__ void operator()(const pg8::f32x4 (&acc)[2][2][4][2], const pg8::Unit& u, int wr, int wc, int fr, int fq) const {
        using namespace pg8;
        const int row0 = u.pm * BM + wr * 64 + fr, col0 = u.pn * BM + wc * 32 + 4 * fq;
#pragma unroll
        for (int ai = 0; ai < 2; ++ai)
#pragma unroll
            for (int m = 0; m < 4; ++m) { const size_t ro = (size_t)(row0 + ai * HALF + m * 16) * D + col0;
#pragma unroll
                for (int bj = 0; bj < 2; ++bj)
#pragma unroll
                    for (int n = 0; n < 2; ++n) { const size_t o = ro + bj * HALF + n * 16; *(f32x4*)(out + o) = *(const f32x4*)(x + o) + acc[ai][bj][m][n]; } }
    }
};
constexpr int GL_QT = 0, GL_KT = 17408, GL_KTT = 34816, GL_VT = 53248, GL_ATT = 90112, GL_BC = 99328, GL_SEG = 132096, GL_EREF = 134144, GL_ELAST = 134656, GL_GLR = 135168, GL_END = 139264;
constexpr int GL_OST = 0;
static_assert(GL_END <= MISC_OFF, "gla lds");
__device__ __forceinline__ pg8::bf16x8 mk8(u64 lo, u64 hi) { pg8::u32x4 v; v.x = (unsigned)lo; v.y = (unsigned)(lo >> 32); v.z = (unsigned)hi; v.w = (unsigned)(hi >> 32); return __builtin_bit_cast(pg8::bf16x8, v); }
__device__ __forceinline__ void gla_unit(Frame& F, int b, int h) {
    using pg8::bf16x8; using pg8::u32x4; using pg8::f32x4;
    const ldsp L = F.lds; const int tid = F.tid, lane = F.lane, w = F.wave, hb = lane >> 5, l32 = lane & 31, l16 = lane & 15, g4 = lane >> 4;
    const bf16* GQ = (const bf16*)(F.ws + WS_GQ); const bf16* GK = (const bf16*)(F.ws + WS_GK); const bf16* GV = (const bf16*)(F.ws + WS_GV); const bf16* GR = (const bf16*)(F.ws + WS_GR);
    const float* GLR = (const float*)(F.ws + WS_GLR); bf16* OA = (bf16*)F.out;
    const float* w2 = F.in[3]; const float* bgk = F.in[4]; const float* gng = F.in[5];
    const int dch = tid & 127, sg = tid >> 7;
    float w2c[16];
#pragma unroll
    for (int r = 0; r < 16; ++r) w2c[r] = w2[r * 512 + h * 128 + dch];
    const float bias = bgk[h * 128 + dch];
    f32x16 st[4];
#pragma unroll
    for (int dt = 0; dt < 4; ++dt)
#pragma unroll
        for (int i = 0; i < 16; ++i) st[dt][i] = 0.f;
    const int tp = tid >> 4, dg = tid & 15, t0 = 2 * tp, d0 = 8 * dg, e0 = 16 * dg;
    const float qscale = 0.08838834764831845f;
    for (int n = 0; n < 32; ++n) {
        const size_t rowbase = (size_t)b * SEQ + n * 64;
        const u32x4 q0 = *(const u32x4*)(GQ + (rowbase + t0) * 512 + h * 128 + d0), q1 = *(const u32x4*)(GQ + (rowbase + t0 + 1) * 512 + h * 128 + d0);
        const u32x4 k0 = *(const u32x4*)(GK + (rowbase + t0) * 512 + h * 128 + d0), k1 = *(const u32x4*)(GK + (rowbase + t0 + 1) * 512 + h * 128 + d0);
        const u32x4 v0a = *(const u32x4*)(GV + (rowbase + t0) * 1024 + h * 256 + e0), v0b = *(const u32x4*)(GV + (rowbase + t0) * 1024 + h * 256 + e0 + 8);
        const u32x4 v1a = *(const u32x4*)(GV + (rowbase + t0 + 1) * 1024 + h * 256 + e0), v1b = *(const u32x4*)(GV + (rowbase + t0 + 1) * 1024 + h * 256 + e0 + 8);
        if (tid < 256) { const f32x4 gl = *(const f32x4*)(GLR + (rowbase + (tid >> 2)) * 16 + (tid & 3) * 4); *(LAS f32x4*)(L + GL_GLR + tid * 16) = gl; }
        __syncthreads();
        {
            float run = 0.f;
#pragma unroll 4
            for (int tt = 0; tt < 16; ++tt) { const int t = 16 * sg + tt; const LAS float* gl = (const LAS float*)(L + GL_GLR + t * 64);
                float z = bias;
#pragma unroll
                for (int r = 0; r < 16; ++r) z += gl[r] * w2c[r];
                run += logsigmoidf_(z) * (1.f / 16.f);
                ((LAS float*)(L + GL_BC))[t * 128 + dch] = run; }
            ((LAS float*)(L + GL_SEG))[sg * 128 + dch] = run;
        }
        __syncthreads();
        {
            const LAS float* BC = (const LAS float*)(L + GL_BC); const LAS float* SG = (const LAS float*)(L + GL_SEG);
            const int sgt = t0 >> 4;
            float qs0[8], qs1[8], ks0[8], ks1[8];
            const unsigned qa[4] = {q0.x, q0.y, q0.z, q0.w}, qb[4] = {q1.x, q1.y, q1.z, q1.w}, ka[4] = {k0.x, k0.y, k0.z, k0.w}, kb[4] = {k1.x, k1.y, k1.z, k1.w};
#pragma unroll
            for (int j = 0; j < 8; ++j) { const int d = d0 + j;
                const float s0 = SG[d], s1 = SG[128 + d], s2 = SG[256 + d];
                const float pre = (sgt > 0 ? s0 : 0.f) + (sgt > 1 ? s1 : 0.f) + (sgt > 2 ? s2 : 0.f);
                const float bref = BC[32 * 128 + d] + s0 + s1;
                const float b0 = BC[t0 * 128 + d] + pre - bref, b1 = BC[(t0 + 1) * 128 + d] + pre - bref;
                const float e0q = __expf(b0), e1q = __expf(b1), e0k = __expf(-b0), e1k = __expf(-b1);
                const float qv0 = (j & 1) ? bf_hi(qa[j >> 1]) : bf_lo(qa[j >> 1]), qv1 = (j & 1) ? bf_hi(qb[j >> 1]) : bf_lo(qb[j >> 1]);
                const float kv0 = (j & 1) ? bf_hi(ka[j >> 1]) : bf_lo(ka[j >> 1]), kv1 = (j & 1) ? bf_hi(kb[j >> 1]) : bf_lo(kb[j >> 1]);
                qs0[j] = qv0 * qscale * e0q; qs1[j] = qv1 * qscale * e1q; ks0[j] = kv0 * e0k; ks1[j] = kv1 * e1k; }
            u32x4 o;
            o.x = pk2(qs0[0], qs0[1]); o.y = pk2(qs0[2], qs0[3]); o.z = pk2(qs0[4], qs0[5]); o.w = pk2(qs0[6], qs0[7]); *(LAS u32x4*)(L + GL_QT + t0 * 272 + d0 * 2) = o;
            o.x = pk2(qs1[0], qs1[1]); o.y = pk2(qs1[2], qs1[3]); o.z = pk2(qs1[4], qs1[5]); o.w = pk2(qs1[6], qs1[7]); *(LAS u32x4*)(L + GL_QT + (t0 + 1) * 272 + d0 * 2) = o;
            o.x = pk2(ks0[0], ks0[1]); o.y = pk2(ks0[2], ks0[3]); o.z = pk2(ks0[4], ks0[5]); o.w = pk2(ks0[6], ks0[7]); *(LAS u32x4*)(L + GL_KT + t0 * 272 + d0 * 2) = o;
            o.x = pk2(ks1[0], ks1[1]); o.y = pk2(ks1[2], ks1[3]); o.z = pk2(ks1[4], ks1[5]); o.w = pk2(ks1[6], ks1[7]); *(LAS u32x4*)(L + GL_KT + (t0 + 1) * 272 + d0 * 2) = o;
#pragma unroll
            for (int j = 0; j < 8; ++j) *(LAS unsigned*)(L + GL_KTT + (d0 + j) * 144 + t0 * 2) = pk2(ks0[j], ks1[j]);
            const unsigned va[8] = {v0a.x, v0a.y, v0a.z, v0a.w, v0b.x, v0b.y, v0b.z, v0b.w}, vb[8] = {v1a.x, v1a.y, v1a.z, v1a.w, v1b.x, v1b.y, v1b.z, v1b.w};
#pragma unroll
            for (int j = 0; j < 16; ++j) { const unsigned a = va[j >> 1], c = vb[j >> 1];
                const unsigned pk = (j & 1) ? ((a >> 16) | (c & 0xffff0000u)) : ((a & 0xffffu) | (c << 16));
                *(LAS unsigned*)(L + GL_VT + (e0 + j) * 144 + t0 * 2) = pk; }
            if (tid < 128) { const int d = tid; const float s0 = SG[d], s1 = SG[128 + d], s2 = SG[256 + d];
                const float bref = BC[32 * 128 + d] + s0 + s1, blast = BC[63 * 128 + d] + s0 + s1 + s2;
                ((LAS float*)(L + GL_EREF))[d] = __expf(bref); ((LAS float*)(L + GL_ELAST))[d] = __expf(blast - bref); }
        }
        __syncthreads();
        f32x16 oacc[2];
#pragma unroll
        for (int i = 0; i < 16; ++i) { oacc[0][i] = 0.f; oacc[1][i] = 0.f; }
        {
            const LAS float* ER = (const LAS float*)(L + GL_EREF);
#pragma unroll
            for (int dt = 0; dt < 4; ++dt) {
#pragma unroll
                for (int i = 0; i < 16; ++i) st[dt][i] *= ER[32 * dt + 8 * (i >> 2) + 4 * hb + (i & 3)];
#pragma unroll
                for (int ks = 0; ks < 2; ++ks) {
                    u32x4 bb; bb.x = pk2(st[dt][8 * ks + 0], st[dt][8 * ks + 1]); bb.y = pk2(st[dt][8 * ks + 2], st[dt][8 * ks + 3]); bb.z = pk2(st[dt][8 * ks + 4], st[dt][8 * ks + 5]); bb.w = pk2(st[dt][8 * ks + 6], st[dt][8 * ks + 7]);
                    const bf16x8 B = __builtin_bit_cast(bf16x8, bb);
#pragma unroll
                    for (int tt = 0; tt < 2; ++tt) { const int t = 32 * tt + l32; const int dbase = 32 * dt + 16 * ks + 4 * hb;
                        const u64 lo = *(const LAS u64*)(L + GL_QT + t * 272 + dbase * 2), hi = *(const LAS u64*)(L + GL_QT + t * 272 + (dbase + 8) * 2);
                        oacc[tt] = __builtin_amdgcn_mfma_f32_32x32x16_bf16(mk8(lo, hi), B, oacc[tt], 0, 0, 0); }
                }
            }
        }
        {
            const int tt4 = w >> 1;
#pragma unroll
            for (int q = 0; q < 2; ++q) { const int st4 = 2 * (w & 1) + q; f32x4 a4 = {0.f, 0.f, 0.f, 0.f};
#pragma unroll
                for (int ks = 0; ks < 4; ++ks) { const bf16x8 A = *(const LAS bf16x8*)(L + GL_QT + (16 * tt4 + l16) * 272 + (32 * ks + 8 * g4) * 2), Bk = *(const LAS bf16x8*)(L + GL_KT + (16 * st4 + l16) * 272 + (32 * ks + 8 * g4) * 2);
                    a4 = __builtin_amdgcn_mfma_f32_16x16x32_bf16(A, Bk, a4, 0, 0, 0); }
#pragma unroll
                for (int i = 0; i < 4; ++i) { const int t = 16 * tt4 + 4 * g4 + i, s = 16 * st4 + l16; const float v = (s <= t) ? a4[i] : 0.f;
                    *(LAS unsigned short*)(L + GL_ATT + t * 144 + s * 2) = (unsigned short)f2bf(v); } }
        }
        __syncthreads();
        {
            bf16x8 Bv[4];
#pragma unroll
            for (int ks = 0; ks < 4; ++ks) Bv[ks] = *(const LAS bf16x8*)(L + GL_VT + (32 * w + l32) * 144 + (16 * ks + 8 * hb) * 2);
#pragma unroll
            for (int tt = 0; tt < 2; ++tt)
#pragma unroll
                for (int ks = 0; ks < 4; ++ks) { const bf16x8 A = *(const LAS bf16x8*)(L + GL_ATT + (32 * tt + l32) * 144 + (16 * ks + 8 * hb) * 2);
                    oacc[tt] = __builtin_amdgcn_mfma_f32_32x32x16_bf16(A, Bv[ks], oacc[tt], 0, 0, 0); }
            const LAS float* EL = (const LAS float*)(L + GL_ELAST);
#pragma unroll
            for (int dt = 0; dt < 4; ++dt) {
#pragma unroll
                for (int ks = 0; ks < 4; ++ks) { const bf16x8 A = *(const LAS bf16x8*)(L + GL_KTT + (32 * dt + l32) * 144 + (16 * ks + 8 * hb) * 2);
                    st[dt] = __builtin_amdgcn_mfma_f32_32x32x16_bf16(A, Bv[ks], st[dt], 0, 0, 0); }
#pragma unroll
                for (int i = 0; i < 16; ++i) st[dt][i] *= EL[32 * dt + 8 * (i >> 2) + 4 * hb + (i & 3)];
            }
        }
        __syncthreads();
#pragma unroll
        for (int tt = 0; tt < 2; ++tt)
#pragma unroll
            for (int i = 0; i < 16; ++i) ((LAS float*)(L + GL_OST))[(32 * tt + 8 * (i >> 2) + 4 * hb + (i & 3)) * 260 + 32 * w + l32] = oacc[tt][i];
        __syncthreads();
        {
            const int t = tid >> 3, c = tid & 7, ee = 32 * c;
            f32x4 ov[8]; float ss = 0.f;
#pragma unroll
            for (int j = 0; j < 8; ++j) { ov[j] = *(const LAS f32x4*)(L + GL_OST + (t * 260 + ee + 4 * j) * 4); ss += (ov[j].x * ov[j].x + ov[j].y * ov[j].y) + (ov[j].z * ov[j].z + ov[j].w * ov[j].w); }
            ss += __shfl_xor(ss, 1); ss += __shfl_xor(ss, 2); ss += __shfl_xor(ss, 4);
            const float rstd = 1.f / sqrtf(ss * (1.f / 256.f) + EPS);
            const bf16* grp = GR + (rowbase + t) * 1024 + h * 256 + ee; bf16* op = OA + (rowbase + t) * 1024 + h * 256 + ee;
#pragma unroll
            for (int j2 = 0; j2 < 4; ++j2) { const u32x4 gv = *(const u32x4*)(grp + 8 * j2); const f32x4 g0 = *(const f32x4*)(gng + ee + 8 * j2), g1 = *(const f32x4*)(gng + ee + 8 * j2 + 4);
                const f32x4 a = ov[2 * j2], c2 = ov[2 * j2 + 1]; u32x4 o;
                o.x = pk2(a.x * rstd * g0.x * bf_lo(gv.x), a.y * rstd * g0.y * bf_hi(gv.x)); o.y = pk2(a.z * rstd * g0.z * bf_lo(gv.y), a.w * rstd * g0.w * bf_hi(gv.y));
                o.z = pk2(c2.x * rstd * g1.x * bf_lo(gv.z), c2.y * rstd * g1.y * bf_hi(gv.z)); o.w = pk2(c2.z * rstd * g1.z * bf_lo(gv.w), c2.w * rstd * g1.w * bf_hi(gv.w));
                *(u32x4*)(op + 8 * j2) = o; }
        }
    }
}
constexpr int SW_KS = 0, SW_VT = 36864, SW_QS = 36864 + 33792, SW_END = SW_QS + 18432;
static_assert(SW_END <= MISC_OFF, "swa lds");
__device__ __forceinline__ void swa_unit(Frame& F, int b, int qb, int kvh) {
    using pg8::bf16x8; using pg8::u32x4; using pg8::f32x4;
    const ldsp L = F.lds; const int tid = F.tid, lane = F.lane, w = F.wave, l16 = lane & 15, g4 = lane >> 4;
    const bf16* SQ = (const bf16*)(F.ws + WS_SQ); const bf16* SK = (const bf16*)(F.ws + WS_SK); const bf16* SV = (const bf16*)(F.ws + WS_SV);
    const float2* ROPE = (const float2*)(F.ws + WS_ROPE); bf16* OB = (bf16*)F.out + (size_t)T * D;
    const float* qng = F.in[6]; const float* kng = F.in[7]; const float* sinks = F.in[8];
    __syncthreads();
    {
        const int key = tid >> 1, half = tid & 1; const int pos = (qb - 1) * 128 + key;
        float x[32];
        if (pos >= 0) { const u32x4* src = (const u32x4*)(SK + ((size_t)b * SEQ + pos) * 256 + kvh * 64 + 32 * half);
#pragma unroll
            for (int j = 0; j < 4; ++j) { const u32x4 v = src[j]; x[8 * j + 0] = bf_lo(v.x); x[8 * j + 1] = bf_hi(v.x); x[8 * j + 2] = bf_lo(v.y); x[8 * j + 3] = bf_hi(v.y); x[8 * j + 4] = bf_lo(v.z); x[8 * j + 5] = bf_hi(v.z); x[8 * j + 6] = bf_lo(v.w); x[8 * j + 7] = bf_hi(v.w); } }
        else {
#pragma unroll
            for (int j = 0; j < 32; ++j) x[j] = 0.f; }
        float ss = 0.f;
#pragma unroll
        for (int j = 0; j < 32; ++j) ss += x[j] * x[j];
        ss += __shfl_xor(ss, 1);
        const float rstd = 1.f / sqrtf(ss * (1.f / 64.f) + EPS);
#pragma unroll
        for (int j = 0; j < 32; ++j) x[j] = x[j] * rstd * kng[32 * half + j];
        if (half == 0 && pos >= 0) {
#pragma unroll
            for (int j = 0; j < 8; ++j) { const float2 cs = ROPE[pos * 8 + j]; const float a = x[j], c = x[8 + j]; x[j] = a * cs.x - c * cs.y; x[8 + j] = c * cs.x + a * cs.y; } }
#pragma unroll
        for (int j = 0; j < 4; ++j) { u32x4 o; o.x = pk2(x[8 * j], x[8 * j + 1]); o.y = pk2(x[8 * j + 2], x[8 * j + 3]); o.z = pk2(x[8 * j + 4], x[8 * j + 5]); o.w = pk2(x[8 * j + 6], x[8 * j + 7]);
            *(LAS u32x4*)(L + SW_KS + key * 144 + (32 * half + 8 * j) * 2) = o; }
    }
    {
        const int kp = tid >> 2, dq = tid & 3; const int pos0 = (qb - 1) * 128 + 2 * kp;
        u32x4 a0 = {0u, 0u, 0u, 0u}, a1 = a0, c0 = a0, c1 = a0;
        if (pos0 >= 0) { const u32x4* s0 = (const u32x4*)(SV + ((size_t)b * SEQ + pos0) * 256 + kvh * 64 + 16 * dq); const u32x4* s1 = (const u32x4*)(SV + ((size_t)b * SEQ + pos0 + 1) * 256 + kvh * 64 + 16 * dq);
            a0 = s0[0]; a1 = s0[1]; c0 = s1[0]; c1 = s1[1]; }
        const unsigned va[8] = {a0.x, a0.y, a0.z, a0.w, a1.x, a1.y, a1.z, a1.w}, vb[8] = {c0.x, c0.y, c0.z, c0.w, c1.x, c1.y, c1.z, c1.w};
#pragma unroll
        for (int j = 0; j < 16; ++j) { const unsigned a = va[j >> 1], c = vb[j >> 1];
            const unsigned pk = (j & 1) ? ((a >> 16) | (c & 0xffff0000u)) : ((a & 0xffffu) | (c << 16));
            *(LAS unsigned*)(L + SW_VT + (16 * dq + j) * 528 + kp * 4) = pk; }
    }
    for (int gh = 0; gh < 4; ++gh) {
        const int h = kvh * 4 + gh;
        if (gh > 0) __syncthreads();
        {
            const int row = tid >> 2, qq = tid & 3; const int pos = qb * 128 + row;
            const u32x4* src = (const u32x4*)(SQ + ((size_t)b * SEQ + pos) * 1024 + h * 64 + 16 * qq);
            float x[16];
#pragma unroll
            for (int j = 0; j < 2; ++j) { const u32x4 v = src[j]; x[8 * j + 0] = bf_lo(v.x); x[8 * j + 1] = bf_hi(v.x); x[8 * j + 2] = bf_lo(v.y); x[8 * j + 3] = bf_hi(v.y); x[8 * j + 4] = bf_lo(v.z); x[8 * j + 5] = bf_hi(v.z); x[8 * j + 6] = bf_lo(v.w); x[8 * j + 7] = bf_hi(v.w); }
            float ss = 0.f;
#pragma unroll
            for (int j = 0; j < 16; ++j) ss += x[j] * x[j];
            ss += __shfl_xor(ss, 1); ss += __shfl_xor(ss, 2);
            const float rstd = 1.f / sqrtf(ss * (1.f / 64.f) + EPS);
#pragma unroll
            for (int j = 0; j < 16; ++j) x[j] = x[j] * rstd * qng[16 * qq + j];
            if (qq == 0) {
#pragma unroll
                for (int j = 0; j < 8; ++j) { const float2 cs = ROPE[pos * 8 + j]; const float a = x[j], c = x[8 + j]; x[j] = a * cs.x - c * cs.y; x[8 + j] = c * cs.x + a * cs.y; } }
#pragma unroll
            for (int j = 0; j < 2; ++j) { u32x4 o; o.x = pk2(0.125f * x[8 * j], 0.125f * x[8 * j + 1]); o.y = pk2(0.125f * x[8 * j + 2], 0.125f * x[8 * j + 3]); o.z = pk2(0.125f * x[8 * j + 4], 0.125f * x[8 * j + 5]); o.w = pk2(0.125f * x[8 * j + 6], 0.125f * x[8 * j + 7]);
                *(LAS u32x4*)(L + SW_QS + row * 144 + (16 * qq + 8 * j) * 2) = o; }
        }
        __syncthreads();
        const int kt0 = w < 6 ? w : 6;
        const int qi = 16 * w + l16;
        bf16x8 qf[2];
#pragma unroll
        for (int ks = 0; ks < 2; ++ks) qf[ks] = *(const LAS bf16x8*)(L + SW_QS + qi * 144 + (32 * ks + 8 * g4) * 2);
        const float sink = sinks[h];
        float sc[10][4]; float mx = sink;
#pragma unroll
        for (int t = 0; t < 10; ++t) { const int kt = kt0 + t; f32x4 a4 = {0.f, 0.f, 0.f, 0.f};
#pragma unroll
            for (int ks = 0; ks < 2; ++ks) { const bf16x8 A = *(const LAS bf16x8*)(L + SW_KS + (16 * kt + l16) * 144 + (32 * ks + 8 * g4) * 2);
                a4 = __builtin_amdgcn_mfma_f32_16x16x32_bf16(A, qf[ks], a4, 0, 0, 0); }
#pragma unroll
            for (int i = 0; i < 4; ++i) { const int kp = 16 * kt + 4 * g4 + i; const bool valid = (kp > qi) && (kp <= qi + 128) && (qb > 0 || kp >= 128);
                sc[t][i] = valid ? a4[i] : -1e30f; mx = fmaxf(mx, sc[t][i]); } }
        mx = fmaxf(mx, __shfl_xor(mx, 16)); mx = fmaxf(mx, __shfl_xor(mx, 32));
        float sum = 0.f;
#pragma unroll
        for (int t = 0; t < 10; ++t)
#pragma unroll
            for (int i = 0; i < 4; ++i) { const float p = (sc[t][i] > -1e29f) ? __expf(sc[t][i] - mx) : 0.f; sc[t][i] = p; sum += p; }
        sum += __shfl_xor(sum, 16); sum += __shfl_xor(sum, 32);
        const float inv = 1.f / (sum + __expf(sink - mx));
        f32x4 o4[4];
#pragma unroll
        for (int dt = 0; dt < 4; ++dt) o4[dt] = (f32x4){0.f, 0.f, 0.f, 0.f};
#pragma unroll
        for (int pp = 0; pp < 5; ++pp) { const int ta = 2 * pp, tb = 2 * pp + 1;
            u32x4 pa; pa.x = pk2(sc[ta][0] * inv, sc[ta][1] * inv); pa.y = pk2(sc[ta][2] * inv, sc[ta][3] * inv); pa.z = pk2(sc[tb][0] * inv, sc[tb][1] * inv); pa.w = pk2(sc[tb][2] * inv, sc[tb][3] * inv);
            const bf16x8 A = __builtin_bit_cast(bf16x8, pa);
#pragma unroll
            for (int dt = 0; dt < 4; ++dt) { const int d = 16 * dt + l16;
                const u64 lo = *(const LAS u64*)(L + SW_VT + d * 528 + (16 * (kt0 + ta) + 4 * g4) * 2), hi = *(const LAS u64*)(L + SW_VT + d * 528 + (16 * (kt0 + tb) + 4 * g4) * 2);
                o4[dt] = __builtin_amdgcn_mfma_f32_16x16x32_bf16(A, mk8(lo, hi), o4[dt], 0, 0, 0); } }
#pragma unroll
        for (int dt = 0; dt < 4; ++dt)
#pragma unroll
            for (int i = 0; i < 4; ++i) OB[((size_t)b * SEQ + qb * 128 + 16 * w + 4 * g4 + i) * 1024 + h * 64 + 16 * dt + l16] = (bf16)f2bf(o4[dt][i]);
    }
}
constexpr int PK_SK = 0, PK_S12 = 2 * 128 * 272;
static_assert(PK_S12 + 32 * 512 * 4 <= MISC_OFF, "peer lds");
template <class K> __device__ __forceinline__ K kmax_(K a, K b);
template <class K> __device__ __forceinline__ K kmin_(K a, K b);
template <> __device__ __forceinline__ float kmax_<float>(float a, float b) { return fmaxf(a, b); }
template <> __device__ __forceinline__ float kmin_<float>(float a, float b) { return fminf(a, b); }
struct K2 { unsigned h, l; };
template <> __device__ __forceinline__ K2 kmax_<K2>(K2 a, K2 b) { const bool gt = a.h > b.h; K2 r; r.h = gt ? a.h : b.h; r.l = gt ? a.l : b.l; return r; }
template <> __device__ __forceinline__ K2 kmin_<K2>(K2 a, K2 b) { const bool gt = a.h > b.h; K2 r; r.h = gt ? b.h : a.h; r.l = gt ? b.l : a.l; return r; }
template <class K> __device__ __forceinline__ void ce_(K& a, K& b, bool desc) { const K hi = kmax_<K>(a, b), lo = kmin_<K>(a, b); a = desc ? hi : lo; b = desc ? lo : hi; }
template <class K> __device__ __forceinline__ void sort16_desc(K* v) {
#pragma unroll
    for (int k = 2; k <= 16; k <<= 1)
#pragma unroll
        for (int j = k >> 1; j > 0; j >>= 1)
#pragma unroll
            for (int i = 0; i < 16; ++i) { const int l = i ^ j; if (l > i) ce_<K>(v[i], v[l], (i & k) == 0); }
}
template <class K> __device__ __forceinline__ void bmerge16_desc(K* v) {
#pragma unroll
    for (int j = 8; j > 0; j >>= 1)
#pragma unroll
        for (int i = 0; i < 16; ++i) { const int l = i ^ j; if (l > i) ce_<K>(v[i], v[l], true); }
}
template <class K> __device__ __forceinline__ void merge_top16(K* a, const K* b) {
#pragma unroll
    for (int i = 0; i < 16; ++i) a[i] = kmax_<K>(a[i], b[15 - i]);
    bmerge16_desc<K>(a);
}
template <class K> __device__ __forceinline__ void top16_of_64(K* v) {
    sort16_desc<K>(v); sort16_desc<K>(v + 16); sort16_desc<K>(v + 32); sort16_desc<K>(v + 48);
    merge_top16<K>(v, v + 16); merge_top16<K>(v + 32, v + 48); merge_top16<K>(v, v + 32);
}
__device__ __forceinline__ unsigned ford(float f) { const unsigned u = __builtin_bit_cast(unsigned, f); return (u & 0x80000000u) ? ~u : (u | 0x80000000u); }
__device__ __forceinline__ float funord(unsigned k) { const unsigned u = (k & 0x80000000u) ? (k & 0x7fffffffu) : ~k; return __builtin_bit_cast(float, u); }

__device__ const unsigned char STAIR[64] = {0, 1, 2, 3, 4, 5, 6, 7, 8, 9, 10, 11, 12, 13, 14, 15, 16, 17, 18, 19, 20, 21, 22, 23, 32, 33, 34, 35, 36, 48, 49, 50, 51, 64, 65, 66, 80, 81, 96, 97, 112, 113, 128, 144, 160, 176, 192, 208, 224, 240, 0, 0, 0, 0, 0, 0, 0, 0, 0, 0, 0, 0, 0, 0};
__device__ __forceinline__ void peer_topk_unit(Frame& F, int tile, int hh) {
    using pg8::bf16x8; using pg8::u32x4;
    const ldsp L = F.lds; const int tid = F.tid, lane = F.lane, w = F.wave, hb = lane >> 5, l32 = lane & 31;
    const bf16* QP = (const bf16*)(F.ws + WS_QP); const bf16* SUBK = (const bf16*)(F.ws + WS_SUBK);
    int* IDX = (int*)(F.ws + WS_IDX); float* GATE = (float*)(F.ws + WS_GATE);
    __syncthreads();
    {
        const u32x4* src = (const u32x4*)(SUBK + (size_t)hh * 2 * 128 * 128);
#pragma unroll
        for (int r = 0; r < 8; ++r) { const int idx = tid + r * NTHR; const int row = idx >> 4, c = idx & 15;
            *(LAS u32x4*)(L + PK_SK + row * 272 + c * 16) = src[idx]; }
    }
    __syncthreads();
    const int tok = tile * 256 + 32 * w + l32;
    LAS float* S12 = (LAS float*)(L + PK_S12) + tid;
#pragma unroll 1
    for (int p = 0; p < 2; ++p) {
        bf16x8 Bq[8];
        const u32x4* qsrc = (const u32x4*)(QP + (size_t)tok * 2048 + (2 * hh + p) * 128);
#pragma unroll
        for (int ks = 0; ks < 8; ++ks) Bq[ks] = __builtin_bit_cast(bf16x8, qsrc[2 * ks + hb]);
        float v[16];
#pragma unroll
        for (int kt = 0; kt < 4; ++kt) { f32x16 acc;
#pragma unroll
            for (int i = 0; i < 16; ++i) acc[i] = 0.f;
#pragma unroll
            for (int ks = 0; ks < 8; ++ks) { const bf16x8 A = *(const LAS bf16x8*)(L + PK_SK + (p * 128 + 32 * kt + l32) * 272 + (16 * ks + 8 * hb) * 2);
                acc = __builtin_amdgcn_mfma_f32_32x32x16_bf16(A, Bq[ks], acc, 0, 0, 0); }
            float cur[16];
#pragma unroll
            for (int i = 0; i < 16; ++i) { const int key = 32 * kt + 8 * (i >> 2) + 4 * hb + (i & 3);
                cur[i] = __builtin_bit_cast(float, (__builtin_bit_cast(unsigned, acc[i]) & ~127u) | (unsigned)(127 - key)); }
            sort16_desc<float>(cur);
            if (kt == 0) {
#pragma unroll
                for (int i = 0; i < 16; ++i) v[i] = cur[i]; }
            else merge_top16<float>(v, cur);
            __builtin_amdgcn_sched_barrier(0); }
        float o[16];
#pragma unroll
        for (int i = 0; i < 16; ++i) o[i] = __shfl_xor(v[15 - i], 32);
#pragma unroll
        for (int i = 0; i < 16; ++i) v[i] = fmaxf(v[i], o[i]);
        bmerge16_desc<float>(v);
#pragma unroll
        for (int i = 0; i < 16; ++i) S12[(p * 16 + i) * NTHR] = v[i];
    }
    float s12[2][16];
#pragma unroll
    for (int p = 0; p < 2; ++p)
#pragma unroll
        for (int i = 0; i < 16; ++i) s12[p][i] = S12[(p * 16 + i) * NTHR];
    float c[16];
#pragma unroll
    for (int gq = 0; gq < 4; ++gq) {
        float cur[16];
#pragma unroll
        for (int q = 0; q < 16; ++q) cur[q] = -3.0e38f;
        int n = 0;
#pragma unroll
        for (int i = 0; i < 16; ++i)
#pragma unroll
            for (int j = 0; j < 16; ++j) if ((i + 1) * (j + 1) <= 16) {
                if ((n >> 4) == gq) {
                    const unsigned b1 = __builtin_bit_cast(unsigned, s12[0][i]), b2 = __builtin_bit_cast(unsigned, s12[1][j]);
                    const float sum = __builtin_bit_cast(float, b1 & ~127u) + __builtin_bit_cast(float, b2 & ~127u);
                    cur[n & 15] = __builtin_bit_cast(float, (__builtin_bit_cast(unsigned, sum) & ~63u) | (unsigned)n); }
                ++n; }
        sort16_desc<float>(cur);
        if (gq == 0) {
#pragma unroll
            for (int q = 0; q < 16; ++q) c[q] = cur[q]; }
        else merge_top16<float>(c, cur);
        __builtin_amdgcn_sched_barrier(0);
    }
    float best[16]; int eidx[16]; float m = -3.0e38f;
#pragma unroll
    for (int k = 0; k < 16; ++k) { const unsigned cid = __builtin_bit_cast(unsigned, c[k]) & 63u; const unsigned ij = STAIR[cid];
        const unsigned b1 = __builtin_bit_cast(unsigned, S12[(ij >> 4) * NTHR]), b2 = __builtin_bit_cast(unsigned, S12[(16 + (ij & 15u)) * NTHR]);
        best[k] = __builtin_bit_cast(float, b1 & ~127u) + __builtin_bit_cast(float, b2 & ~127u); m = fmaxf(m, best[k]);
        eidx[k] = (int)(((127u - (b1 & 127u)) << 7) | (127u - (b2 & 127u))); }
    float sum = 0.f;
#pragma unroll
    for (int k = 0; k < 16; ++k) { best[k] = __expf(best[k] - m); sum += best[k]; }
    const float inv = 1.f / sum;
    if (hb == 0) { int4* dst = (int4*)(IDX + (size_t)tok * 128 + hh * 16);
#pragma unroll
        for (int k4 = 0; k4 < 4; ++k4) dst[k4] = make_int4(eidx[4 * k4], eidx[4 * k4 + 1], eidx[4 * k4 + 2], eidx[4 * k4 + 3]); }
    else { float4* dst = (float4*)(GATE + (size_t)tok * 128 + hh * 16);
#pragma unroll
        for (int k4 = 0; k4 < 4; ++k4) dst[k4] = make_float4(best[4 * k4] * inv, best[4 * k4 + 1] * inv, best[4 * k4 + 2] * inv, best[4 * k4 + 3] * inv); }
}


__device__ __forceinline__ void wave_argmax(float& v, int& p) {
#pragma unroll
    for (int o = 1; o < 64; o <<= 1) { const float ov = __shfl_xor(v, o); const int op = __shfl_xor(p, o); const bool t = (ov > v) || (ov == v && op < p); v = t ? ov : v; p = t ? op : p; }
}
__device__ __forceinline__ void peer_topk_slow(Frame& F, int tok, int hh) {
    using pg8::u32x4;
    const int lane = F.lane;
    const bf16* QP = (const bf16*)(F.ws + WS_QP) + (size_t)tok * 2048 + hh * 256; const bf16* SUBK = (const bf16*)(F.ws + WS_SUBK) + (size_t)hh * 2 * 128 * 128;
    float sv[2] = {0.f, 0.f}; int sk[2] = {0, 0};
#pragma unroll 1
    for (int p = 0; p < 2; ++p) {
        float sc0 = 0.f, sc1 = 0.f;
        const u32x4* q4 = (const u32x4*)(QP + p * 128); const u32x4* k0 = (const u32x4*)(SUBK + ((size_t)p * 128 + lane) * 128); const u32x4* k1 = (const u32x4*)(SUBK + ((size_t)p * 128 + lane + 64) * 128);
#pragma unroll 4
        for (int c = 0; c < 16; ++c) { const u32x4 q = q4[c], a = k0[c], b = k1[c];
            sc0 += bf_lo(q.x) * bf_lo(a.x) + bf_hi(q.x) * bf_hi(a.x) + bf_lo(q.y) * bf_lo(a.y) + bf_hi(q.y) * bf_hi(a.y) + bf_lo(q.z) * bf_lo(a.z) + bf_hi(q.z) * bf_hi(a.z) + bf_lo(q.w) * bf_lo(a.w) + bf_hi(q.w) * bf_hi(a.w);
            sc1 += bf_lo(q.x) * bf_lo(b.x) + bf_hi(q.x) * bf_hi(b.x) + bf_lo(q.y) * bf_lo(b.y) + bf_hi(q.y) * bf_hi(b.y) + bf_lo(q.z) * bf_lo(b.z) + bf_hi(q.z) * bf_hi(b.z) + bf_lo(q.w) * bf_lo(b.w) + bf_hi(q.w) * bf_hi(b.w); }
        float wv = 0.f; int wk = 0;
#pragma unroll 1
        for (int it = 0; it < 16; ++it) { float v = sc0 >= sc1 ? sc0 : sc1; int key = sc0 >= sc1 ? lane : lane + 64;
            wave_argmax(v, key);
            if (key == lane) sc0 = -3.0e38f; if (key == lane + 64) sc1 = -3.0e38f;
            if (lane == it) { wv = v; wk = key; } }
        if (p == 0) { sv[0] = wv; sk[0] = wk; } else { sv[1] = wv; sk[1] = wk; }
    }
    float cv[4]; int cp[4];
#pragma unroll
    for (int r = 0; r < 4; ++r) { const int c = lane + 64 * r, i = c >> 4, j = c & 15; cv[r] = __shfl(sv[0], i) + __shfl(sv[1], j); cp[r] = c; }
    float bv = 0.f; int bp = 0;
#pragma unroll 1
    for (int it = 0; it < 16; ++it) { float v = cv[0]; int c = cp[0];
#pragma unroll
        for (int r = 1; r < 4; ++r) if (cv[r] > v) { v = cv[r]; c = cp[r]; }
        wave_argmax(v, c);
#pragma unroll
        for (int r = 0; r < 4; ++r) if (cp[r] == c) cv[r] = -3.0e38f;
        if (lane == it) { bv = v; bp = c; } }
    const int k1 = __shfl(sk[0], bp >> 4), k2 = __shfl(sk[1], bp & 15);
    float m = bv;
#pragma unroll
    for (int o = 1; o < 16; o <<= 1) m = fmaxf(m, __shfl_xor(m, o));
    const float e = __expf(bv - m); float sum = e;
#pragma unroll
    for (int o = 1; o < 16; o <<= 1) sum += __shfl_xor(sum, o);
    if (lane < 16) { ((int*)(F.ws + WS_IDX))[(size_t)tok * 128 + hh * 16 + lane] = k1 * 128 + k2; ((float*)(F.ws + WS_GATE))[(size_t)tok * 128 + hh * 16 + lane] = e / sum; }
}
__device__ __forceinline__ float gelu_erf(float x) { return 0.5f * x * (1.f + erff(x * 0.70710678118654752f)); }
__device__ __forceinline__ void peer_expert_token(Frame& F, int tok) {
    using pg8::u32x4; using pg8::f32x4;
    const int lane = F.lane;
    const bf16* XN = (const bf16*)(F.ws + WS_XN2) + (size_t)tok * D; const bf16* U = (const bf16*)(F.ws + WS_U); const bf16* V = (const bf16*)(F.ws + WS_V);
    const int* IDX = (const int*)(F.ws + WS_IDX) + (size_t)tok * 128; const float* GATE = (const float*)(F.ws + WS_GATE) + (size_t)tok * 128;
    const u32x4 xa = *(const u32x4*)(XN + 8 * lane), xb = *(const u32x4*)(XN + 512 + 8 * lane);
    const unsigned xw[8] = {xa.x, xa.y, xa.z, xa.w, xb.x, xb.y, xb.z, xb.w};
    const int myidx0 = IDX[lane], myidx1 = IDX[64 + lane]; const float myg0 = GATE[lane], myg1 = GATE[64 + lane];
    float oacc[16];
#pragma unroll
    for (int j = 0; j < 16; ++j) oacc[j] = 0.f;
#pragma unroll 1
    for (int grp = 0; grp < 8; ++grp) {
        const int idxv = grp < 4 ? myidx0 : myidx1; const float gv = grp < 4 ? myg0 : myg1; const int lbase = (grp & 3) * 16;
        float part[16]; int rows[16];
#pragma unroll
        for (int k = 0; k < 16; ++k) rows[k] = __shfl(idxv, lbase + k);
#pragma unroll
        for (int k = 0; k < 16; ++k) { const int row = __builtin_amdgcn_readfirstlane(rows[k]);
            const bf16* up = U + (size_t)row * D; const u32x4 ua = *(const u32x4*)(up + 8 * lane), ub = *(const u32x4*)(up + 512 + 8 * lane);
            const unsigned uw[8] = {ua.x, ua.y, ua.z, ua.w, ub.x, ub.y, ub.z, ub.w};
            float s = 0.f;
#pragma unroll
            for (int q = 0; q < 8; ++q) s = __builtin_amdgcn_fdot2_f32_bf16(__builtin_bit_cast(bf2_t, uw[q]), __builtin_bit_cast(bf2_t, xw[q]), s, false);
            part[k] = s; }
#pragma unroll
        for (int k = 0; k < 16; ++k) part[k] = wave_sum(part[k]);
        float wk[16];
#pragma unroll
        for (int k = 0; k < 16; ++k) wk[k] = gelu_erf(part[k]) * __shfl(gv, lbase + k);
#pragma unroll
        for (int k = 0; k < 16; ++k) { const int row = __builtin_amdgcn_readfirstlane(rows[k]);
            const bf16* vp = V + (size_t)row * D; const u32x4 va = *(const u32x4*)(vp + 8 * lane), vb = *(const u32x4*)(vp + 512 + 8 * lane);
            const unsigned vw[8] = {va.x, va.y, va.z, va.w, vb.x, vb.y, vb.z, vb.w};
#pragma unroll
            for (int q = 0; q < 8; ++q) { oacc[2 * q] += wk[k] * bf_lo(vw[q]); oacc[2 * q + 1] += wk[k] * bf_hi(vw[q]); } }
    }
    float* op = F.out + (size_t)tok * D;
    f32x4 r0 = *(const f32x4*)(op + 8 * lane), r1 = *(const f32x4*)(op + 8 * lane + 4), r2 = *(const f32x4*)(op + 512 + 8 * lane), r3 = *(const f32x4*)(op + 512 + 8 * lane + 4);
    r0.x += oacc[0]; r0.y += oacc[1]; r0.z += oacc[2]; r0.w += oacc[3]; r1.x += oacc[4]; r1.y += oacc[5]; r1.z += oacc[6]; r1.w += oacc[7];
    r2.x += oacc[8]; r2.y += oacc[9]; r2.z += oacc[10]; r2.w += oacc[11]; r3.x += oacc[12]; r3.y += oacc[13]; r3.z += oacc[14]; r3.w += oacc[15];
    *(f32x4*)(op + 8 * lane) = r0; *(f32x4*)(op + 8 * lane + 4) = r1; *(f32x4*)(op + 512 + 8 * lane) = r2; *(f32x4*)(op + 512 + 8 * lane + 4) = r3;
}
struct Args { const float* in[17]; float* out; unsigned char* ws; int ph_lo, ph_hi; };
constexpr int N_PHASES = 10;
__global__ void __launch_bounds__(NTHR, 2) mega_fwd(Args args) {
    extern __shared__ __attribute__((aligned(16))) unsigned char lds[];
    Frame F;
    F.lds = (ldsp)lds; F.ws = args.ws; F.out = args.out;
#pragma unroll
    for (int i = 0; i < 17; ++i) F.in[i] = args.in[i];
    F.tid = threadIdx.x; F.lane = F.tid & 63; F.wave = __builtin_amdgcn_readfirstlane(F.tid >> 6);
    F.G = gridDim.x; { const int bx = blockIdx.x; F.vcu = (F.G % 8 == 0) ? (bx % 8) * (F.G / 8) + bx / 8 : bx; }
    volatile LAS unsigned* MISC = (volatile LAS unsigned*)(F.lds + MISC_OFF);
    if (F.tid < 64) MISC[F.tid] = 0u;
    __syncthreads();
    XcdBarrier bar = xcd_barrier_post((unsigned*)(args.ws + WS_CTL) + CW_BAR, MISC + 8);
    const int lo = args.ph_lo, hi = args.ph_hi;
#define IN(k) (lo <= (k) && (k) < hi)
#define SEAM(k) do { if (IN(k) && IN((k) + 1)) xcd_barrier(bar); } while (0)

    #ifndef NO_P0
    if (IN(0)) { p0_prologue(F); }
#endif
    SEAM(0);
    if (IN(1)) {
        pg8::Gemm g{(const pg8::bf16_t*)(F.ws + WS_H), (const pg8::bf16_t*)(F.ws + WS_WIN), T, NPROJ, D}; pg8::StaticOrder S; S.init(T, NPROJ, F.G, (int)blockIdx.x);
        EpiB<0> E{F.ws}; pg8::gemm_phase<EpiB<0>, pg8::StaticOrder, true, true>(F.lds, g, S, E);
    } SEAM(1);
#ifndef NO_P2
    if (IN(2)) {
        const int nG = (F.G >= 128) ? 64 : (F.G / 2 > 0 ? F.G / 2 : 1);
        if (F.G == 1) { for (int u = 0; u < 64; ++u) gla_unit(F, u >> 2, u & 3); for (int u = 0; u < 1024; ++u) swa_unit(F, u >> 6, (u >> 2) & 15, u & 3); }
        else if (F.vcu < nG) { for (int u = F.vcu; u < 64; u += nG) gla_unit(F, u >> 2, u & 3); }
        else { const int nS = F.G - nG; for (int u = F.vcu - nG; u < 1024; u += nS) swa_unit(F, u >> 6, (u >> 2) & 15, u & 3); }
    }
#endif
    SEAM(2);
    if (IN(3)) {
        { pg8::Gemm g{(const pg8::bf16_t*)F.out, (const pg8::bf16_t*)(F.ws + WS_WA), T, D, D}; pg8::StaticOrder S; S.init(T, D, F.G, (int)blockIdx.x);
          EpiB<1> E{F.ws}; pg8::gemm_phase<EpiB<1>, pg8::StaticOrder, true, true>(F.lds, g, S, E); }
        asm volatile("s_waitcnt vmcnt(0)" ::: "memory"); __syncthreads();
        { pg8::Gemm g{(const pg8::bf16_t*)F.out + (size_t)T * D, (const pg8::bf16_t*)(F.ws + WS_WB), T, D, D}; pg8::StaticOrder S; S.init(T, D, F.G, (int)blockIdx.x);
          EpiB<2> E{F.ws}; pg8::gemm_phase<EpiB<2>, pg8::StaticOrder, true, true>(F.lds, g, S, E); }
    } SEAM(3);
    if (IN(4)) {
        pg8::Gemm g{(const pg8::bf16_t*)(F.ws + WS_YA), (const pg8::bf16_t*)(F.ws + WS_WO), T, D, D}; pg8::StaticOrder S; S.init(T, D, F.G, (int)blockIdx.x);
        EpiX1 E{F.in[0], F.out}; pg8::gemm_phase<EpiX1, pg8::StaticOrder, true, true>(F.lds, g, S, E);
    } SEAM(4);
    if (IN(5)) {
        const int gw = F.vcu * NWAVES + F.wave, NGW = F.G * NWAVES;
        for (int m = gw; m < T; m += NGW) rms_row_to_bf16(F.lane, F.out + (size_t)m * D, F.in[12], (bf16*)(F.ws + WS_XN2) + (size_t)m * D);
        const size_t gtid = (size_t)F.vcu * NTHR + F.tid, gthreads = (size_t)F.G * NTHR;
        cvt_rows_bf16(F.in[15], (bf16*)(F.ws + WS_U), (size_t)16384 * D / 8, gtid, gthreads);
        cvt_rows_bf16(F.in[16], (bf16*)(F.ws + WS_V), (size_t)16384 * D / 8, gtid, gthreads);
    } SEAM(5);
    if (IN(6)) {
        pg8::Gemm g{(const pg8::bf16_t*)(F.ws + WS_XN2), (const pg8::bf16_t*)(F.ws + WS_WPQ), T, 2048, D}; pg8::StaticOrder S; S.init(T, 2048, F.G, (int)blockIdx.x);
        EpiB<3> E{F.ws}; pg8::gemm_phase<EpiB<3>, pg8::StaticOrder, true, true>(F.lds, g, S, E);
    } SEAM(6);
#ifndef NO_P7
#ifdef SLOW_TOPK
    if (IN(7)) { const int gw = F.vcu * NWAVES + F.wave, NGW = F.G * NWAVES; for (int it = gw; it < T * 8; it += NGW) peer_topk_slow(F, it >> 3, it & 7); }
#else
    if (IN(7)) { for (int u = F.vcu; u < 128 * 8; u += F.G) peer_topk_unit(F, u >> 3, u & 7); }
#endif
#endif
    SEAM(7);
#ifndef NO_P8
    if (IN(8)) { const int gw = F.vcu * NWAVES + F.wave, NGW = F.G * NWAVES; for (int tok = gw; tok < T; tok += NGW) peer_expert_token(F, tok); }
#endif
#undef IN
#undef SEAM
}

extern "C" void kernel_launch(void* const* d_in, const int* in_sizes, int n_in, void* d_out, int out_size, void* d_ws, size_t ws_size, hipStream_t stream) {
    static int grid = 0;
    if (grid == 0) {
        if (n_in != 17 || out_size != T * D || ws_size < WS_END) { fprintf(stderr, "kernel_launch: unexpected shapes (n_in %d out %d ws %zu)\n", n_in, out_size, ws_size); grid = -1; return; }
        int dev = 0, cus = 0, per_cu = 0;
        if (hipGetDevice(&dev) != hipSuccess || hipDeviceGetAttribute(&cus, hipDeviceAttributeMultiprocessorCount, dev) != hipSuccess) { grid = -1; return; }
        if (hipFuncSetAttribute((const void*)mega_fwd, hipFuncAttributeMaxDynamicSharedMemorySize, LDS_BYTES) != hipSuccess) { fprintf(stderr, "kernel_launch: hipFuncSetAttribute failed\n"); grid = -1; return; }
        if (hipOccupancyMaxActiveBlocksPerMultiprocessor(&per_cu, (const void*)mega_fwd, NTHR, LDS_BYTES) != hipSuccess || per_cu < 1) { fprintf(stderr, "kernel_launch: occupancy query gave %d\n", per_cu); per_cu = 1; }
        (void)hipGetLastError();
        grid = cus;
    }
    if (grid < 0) return;
    (void)hipMemsetAsync((char*)d_ws + WS_CTL, 0, CTL_ZERO_BYTES, stream);
    Args a{};
    for (int i = 0; i < 17; ++i) a.in[i] = (const float*)d_in[i];
    a.out = (float*)d_out; a.ws = (unsigned char*)d_ws;
#ifndef MK_SPLIT
    a.ph_lo = 0; a.ph_hi = N_PHASES;
    void* kargs[] = {&a};
    hipError_t e = hipLaunchCooperativeKernel((const void*)mega_fwd, dim3(grid), dim3(NTHR), kargs, LDS_BYTES, stream);
    if (e != hipSuccess) fprintf(stderr, "kernel_launch: cooperative launch failed: %s\n", hipGetErrorString(e));
#else
    for (int p = 0; p < 9; ++p) { a.ph_lo = p; a.ph_hi = p + 1; hipLaunchKernelGGL(mega_fwd, dim3(grid), dim3(NTHR), LDS_BYTES, stream, a); }
#endif
}
```

```cpp
#include <hip/hip_runtime.h>
#include <cstdio>
#include <cstdint>
namespace pg8 {
#define PG8_LAS __attribute__((address_space(3)))
typedef unsigned short bf16_t;
typedef short bf16x8 __attribute__((ext_vector_type(8)));
typedef float f32x4 __attribute__((ext_vector_type(4)));
typedef unsigned u32x4 __attribute__((ext_vector_type(4)));
constexpr int BM = 256, BK = 64, HALF = 128, HTB = HALF * BK * 2  , STAGE_BYTES = 8 * HTB, NXCD = 8, WGM = 8;

__host__ __device__ __forceinline__ int lds_byte(int r, int c) { const int st = (r >> 4) * 2 + (c >> 5), rr = r & 15, cc = c & 31, ob = rr * 64 + cc * 2; return st * 1024 + (ob ^ (((ob >> 9) & 1) << 5)); }
__host__ __device__ __forceinline__ void stage_rc(int b, int& R, int& C) { const int st = b / 1024, sb = b % 1024, swz = sb ^ (((sb >> 9) & 1) << 5); R = (st >> 1) * 16 + swz / 64; C = (st & 1) * 32 + (swz % 64) / 2; }
__host__ __device__ __forceinline__ int perm32(int rho) { const int n = rho >> 4, i = rho & 15; return 8 * (i >> 2) + 4 * n + (i & 3); }

struct Unit { int pm, pn; };
struct Gemm { const bf16_t* A; const bf16_t* Bt; int M, N, K; };

struct StaticOrder {
    int nM, nN, nwg, G, c;
    __host__ __device__ void init(int M, int N, int G_, int c_) { nM = M / BM; nN = N / BM; nwg = nM * nN; G = G_; c = c_; }
    __host__ __device__ bool next(int i, Unit& u) const {
        const long L = (long)i * G + c; if (L >= nwg) return false;
        int wgid = (int)L; { const int q = nwg / NXCD, r = nwg % NXCD, xcd = wgid % NXCD, off = wgid / NXCD; wgid = (xcd < r ? xcd * (q + 1) : r * (q + 1) + (xcd - r) * q) + off; }
        const int nig = WGM * nN, gid = wgid / nig, fm = gid * WGM, gsz = (nM - fm) < WGM ? (nM - fm) : WGM;
        u.pm = fm + ((wgid % nig) % gsz); u.pn = (wgid % nig) / gsz; return true;
    }
    __device__ __forceinline__ void a_ready(const Unit&) const {}
    __device__ __forceinline__ void done(const Unit&) const {}
};
__device__ __forceinline__ unsigned cvt_pk_bf16(float lo, float hi) { unsigned r; asm volatile("v_cvt_pk_bf16_f32 %0, %1, %2" : "=v"(r) : "v"(lo), "v"(hi)); return r; }
typedef float f32x2 __attribute__((ext_vector_type(2)));
template <class Epi, class Sched, bool ALIGN_EPI = false, bool SP2 = false>
__device__ __forceinline__ void gemm_phase(PG8_LAS unsigned char* lds, const Gemm g, const Sched& S, const Epi& E) {
    const int tid = threadIdx.x, wid = __builtin_amdgcn_readfirstlane(tid >> 6), lane = tid & 63, wr = wid >> 2, wc = wid & 3, fr = lane & 15, fq = lane >> 4;
    const int K = g.K, nt = K / BK;
    unsigned voffA[2], voffB[2];
#pragma unroll
    for (int i = 0; i < 2; ++i) { int R, C; stage_rc(tid * 16 + i * 8192, R, C); const int Rb = Epi::PERM ? ((R & ~31) + perm32(R & 31)) : R;
        voffA[i] = (unsigned)(R * K + C) * 2u; voffB[i] = (unsigned)(Rb * K + C) * 2u; }
    const size_t kstep = (size_t)(BK * 2);
    const size_t hstep = (size_t)HALF * K * 2;
    const size_t tstep = 2 * hstep;
    const unsigned ldsw = (unsigned)wid * 1024u;
    const int aoff = lds_byte(wr * 64 + fr, fq * 8), boff = lds_byte(wc * 32 + fr, fq * 8);
#define PG8_SA(b, h) (((b) * 2 + (h)) * HTB)
#define PG8_SB(b, h) ((4 + (b) * 2 + (h)) * HTB)
#define PG8_STAGE(bufoff, gbase, voff) do { _Pragma("unroll") for (int _i = 0; _i < 2; ++_i) \
        __builtin_amdgcn_global_load_lds((const unsigned*)((const char*)(gbase) + (voff)[_i]), (PG8_LAS unsigned*)(lds + (bufoff) + ldsw + _i * 8192), 16, 0, 0); } while (0)
#define PG8_LDA(dst, b, h) do { _Pragma("unroll") for (int m = 0; m < 4; ++m) _Pragma("unroll") for (int k = 0; k < 2; ++k) dst[m][k] = *(const PG8_LAS bf16x8*)(lds + PG8_SA(b, h) + aoff + m * 2048 + k * 1024); } while (0)
#define PG8_LDB(dst, b, h) do { _Pragma("unroll") for (int n = 0; n < 2; ++n) _Pragma("unroll") for (int k = 0; k < 2; ++k) dst[n][k] = *(const PG8_LAS bf16x8*)(lds + PG8_SB(b, h) + boff + n * 2048 + k * 1024); } while (0)
#define PG8_MMA(ai, bj, At, Bt) do { __builtin_amdgcn_s_setprio(1); _Pragma("unroll") for (int m = 0; m < 4; ++m) _Pragma("unroll") for (int n = 0; n < 2; ++n) _Pragma("unroll") for (int k = 0; k < 2; ++k) \
        acc[ai][bj][m][n] = __builtin_amdgcn_mfma_f32_16x16x32_bf16(Bt[n][k], At[m][k], acc[ai][bj][m][n], 0, 0, 0); __builtin_amdgcn_s_setprio(0); } while (0)
#define PG8_WAIT_V(n) asm volatile("s_waitcnt vmcnt(" #n ")" ::: "memory")
#define PG8_WAIT_L(n) asm volatile("s_waitcnt lgkmcnt(" #n ")" ::: "memory")
#define PG8_BAR __builtin_amdgcn_s_barrier()
#define PG8_SCHED __builtin_amdgcn_sched_barrier(0)
    Unit cur, nxt; int ui = 0;
    if (!S.next(0, cur)) return;
    f32x4 acc[2][2][4][2];
#pragma unroll
    for (int a = 0; a < 2; ++a)
#pragma unroll
        for (int b = 0; b < 2; ++b)
#pragma unroll
            for (int m = 0; m < 4; ++m)
#pragma unroll
                for (int n = 0; n < 2; ++n) acc[a][b][m][n] = (f32x4){0.f, 0.f, 0.f, 0.f};
    bf16x8 At[4][2], B0[2][2], B1[2][2];
    const char* cA = (const char*)g.A + (size_t)cur.pm * tstep; const char* cB = (const char*)g.Bt + (size_t)cur.pn * tstep;
    S.a_ready(cur);
    if constexpr (SP2) {
        PG8_STAGE(PG8_SB(0, 0), cB, voffB); PG8_STAGE(PG8_SB(0, 1), cB + hstep, voffB); PG8_STAGE(PG8_SA(0, 0), cA, voffA); PG8_STAGE(PG8_SA(0, 1), cA + hstep, voffA);
        if (wr == 1) PG8_BAR;
        PG8_WAIT_V(2); PG8_BAR;
        PG8_STAGE(PG8_SB(1, 0), cB + kstep, voffB); PG8_STAGE(PG8_SA(1, 0), cA + kstep, voffA); PG8_STAGE(PG8_SB(1, 1), cB + hstep + kstep, voffB);
        PG8_WAIT_V(6); PG8_BAR;
    } else {
        PG8_STAGE(PG8_SB(0, 0), cB, voffB); PG8_STAGE(PG8_SA(0, 0), cA, voffA); PG8_STAGE(PG8_SB(0, 1), cB + hstep, voffB); PG8_STAGE(PG8_SA(0, 1), cA + hstep, voffA);
        if (wr == 1) PG8_BAR;
        PG8_WAIT_V(4); PG8_BAR;
        PG8_STAGE(PG8_SB(1, 0), cB + kstep, voffB); PG8_STAGE(PG8_SA(1, 0), cA + kstep, voffA); PG8_STAGE(PG8_SB(1, 1), cB + hstep + kstep, voffB);
        PG8_WAIT_V(6); PG8_BAR;
    }
    for (;;) {
        const bool has_next = S.next(ui + 1, nxt);
        const char* nA = has_next ? (const char*)g.A + (size_t)nxt.pm * tstep : cA; const char* nB = has_next ? (const char*)g.Bt + (size_t)nxt.pn * tstep : cB;
        for (int t = 0; t < nt; t += 2) {
            const bool last = (t == nt - 2);
            const char* a1 = cA + (size_t)(t + 1) * kstep;
            const char* a2 = last ? nA : cA + (size_t)(t + 2) * kstep; const char* b2 = last ? nB : cB + (size_t)(t + 2) * kstep;
            const char* a3 = a2 + kstep; const char* b3 = b2 + kstep;
            if (last && has_next) S.a_ready(nxt);
            if constexpr (SP2) {
            PG8_LDB(B0, 0, 0); PG8_LDB(B1, 0, 1); PG8_SCHED; PG8_LDA(At, 0, 0); PG8_STAGE(PG8_SA(1, 1), a1 + hstep, voffA);
            PG8_WAIT_V(8); PG8_WAIT_L(0); PG8_BAR; PG8_MMA(0, 0, At, B0); PG8_MMA(0, 1, At, B1); PG8_BAR; PG8_SCHED;
            PG8_LDA(At, 0, 1); PG8_STAGE(PG8_SB(0, 0), b2, voffB); PG8_STAGE(PG8_SB(0, 1), b2 + hstep, voffB); PG8_STAGE(PG8_SA(0, 0), a2, voffA);
            PG8_WAIT_V(8); PG8_WAIT_L(0); PG8_BAR; PG8_MMA(1, 0, At, B0); PG8_MMA(1, 1, At, B1); PG8_BAR; PG8_SCHED;
            PG8_LDB(B0, 1, 0); PG8_LDB(B1, 1, 1); PG8_SCHED; PG8_LDA(At, 1, 0); PG8_STAGE(PG8_SA(0, 1), a2 + hstep, voffA);
            PG8_WAIT_V(8); PG8_WAIT_L(0); PG8_BAR; PG8_MMA(0, 0, At, B0); PG8_MMA(0, 1, At, B1); PG8_BAR; PG8_SCHED;
            PG8_LDA(At, 1, 1); PG8_STAGE(PG8_SB(1, 0), b3, voffB); PG8_STAGE(PG8_SB(1, 1), b3 + hstep, voffB); PG8_STAGE(PG8_SA(1, 0), a3, voffA);
            PG8_WAIT_V(8); PG8_WAIT_L(0); PG8_BAR; PG8_MMA(1, 0, At, B0); PG8_MMA(1, 1, At, B1); PG8_BAR; PG8_SCHED;
            } else {
            PG8_LDB(B0, 0, 0); PG8_SCHED; PG8_LDA(At, 0, 0); PG8_STAGE(PG8_SA(1, 1), a1 + hstep, voffA);
            PG8_WAIT_L(8); PG8_BAR; PG8_WAIT_L(0); PG8_MMA(0, 0, At, B0); PG8_BAR; PG8_SCHED;
            PG8_LDB(B1, 0, 1); PG8_STAGE(PG8_SB(0, 0), b2, voffB);
            PG8_BAR; PG8_WAIT_L(0); PG8_MMA(0, 1, At, B1); PG8_BAR;
            PG8_LDA(At, 0, 1); PG8_STAGE(PG8_SA(0, 0), a2, voffA);
            PG8_BAR; PG8_WAIT_L(0); PG8_MMA(1, 0, At, B0); PG8_BAR; PG8_SCHED;
            PG8_STAGE(PG8_SB(0, 1), b2 + hstep, voffB);
            PG8_WAIT_V(6); PG8_BAR; PG8_MMA(1, 1, At, B1); PG8_BAR;
            PG8_LDB(B0, 1, 0); PG8_SCHED; PG8_LDA(At, 1, 0); PG8_STAGE(PG8_SA(0, 1), a2 + hstep, voffA);
            PG8_WAIT_L(8); PG8_BAR; PG8_WAIT_L(0); PG8_MMA(0, 0, At, B0); PG8_BAR; PG8_SCHED;
            PG8_LDB(B1, 1, 1); PG8_STAGE(PG8_SB(1, 0), b3, voffB);
            PG8_BAR; PG8_WAIT_L(0); PG8_MMA(0, 1, At, B1); PG8_BAR;
            PG8_LDA(At, 1, 1); PG8_STAGE(PG8_SA(1, 0), a3, voffA);
            PG8_BAR; PG8_WAIT_L(0); PG8_MMA(1, 0, At, B0); PG8_BAR; PG8_SCHED;
            PG8_STAGE(PG8_SB(1, 1), b3 + hstep, voffB);
            PG8_WAIT_V(6); PG8_BAR; PG8_MMA(1, 1, At, B1); PG8_BAR;
            }
        }
        if constexpr (ALIGN_EPI) { if (wr == 0) PG8_BAR; }
        if constexpr (!Epi::AFTER_DRAIN) { E(acc, cur, wr, wc, fr, fq); S.done(cur); }
        if (!has_next) break;
#pragma unroll
        for (int a = 0; a < 2; ++a)
#pragma unroll
            for (int b = 0; b < 2; ++b)
#pragma unroll
                for (int m = 0; m < 4; ++m)
#pragma unroll
                    for (int n = 0; n < 2; ++n) acc[a][b][m][n] = (f32x4){0.f, 0.f, 0.f, 0.f};
        cur = nxt; cA = nA; cB = nB; ++ui;
        if constexpr (ALIGN_EPI) { if (wr == 1) PG8_BAR; }
    }
    PG8_WAIT_V(0);
    if constexpr (!ALIGN_EPI) { if (wr == 0) PG8_BAR; }
    PG8_BAR;
    if constexpr (Epi::AFTER_DRAIN) { E.fused(acc, cur, wr, wc, fr, fq, lds, wid, lane); S.done(cur); }
#undef PG8_SA
#undef PG8_SB
#undef PG8_STAGE
#undef PG8_LDA
#undef PG8_LDB
#undef PG8_MMA
#undef PG8_WAIT_V
#undef PG8_WAIT_L
#undef PG8_BAR
#undef PG8_SCHED
}
}
#define GAS __attribute__((address_space(1)))
#define LAS __attribute__((address_space(3)))
typedef unsigned short bf16;
typedef unsigned v4u __attribute__((ext_vector_type(4)));
typedef float f32x4 __attribute__((ext_vector_type(4)));
typedef short bf16x8 __attribute__((ext_vector_type(8)));
typedef GAS unsigned gu32;
typedef GAS unsigned long long gu64;
#define RLX_AGENT __ATOMIC_RELAXED, __HIP_MEMORY_SCOPE_AGENT
#define LDS_WAIT() asm volatile("s_waitcnt lgkmcnt(0)" ::: "memory")
#define VM_WAIT() asm volatile("s_waitcnt vmcnt(0)" ::: "memory")
__device__ __forceinline__ unsigned long long rt() { return __builtin_amdgcn_s_memrealtime(); }
__device__ __forceinline__ unsigned f2bf(float f) { unsigned u = __builtin_bit_cast(unsigned, f); return (u + 0x7fffu + ((u >> 16) & 1u)) >> 16; }
__device__ __forceinline__ unsigned pk2(float lo, float hi) { return f2bf(lo) | (f2bf(hi) << 16); }
#define XB_TMO      128
#define XB_XCNT(j)  (256  + 64 * (j))
#define XB_XSUB(j)  (1280 + 64 * (j))
#define XB_XGEN(j)  (2304 + 64 * (j))
#define XB_TOP      3328
#define XB_TOPGEN   3392
#define XCD_BAR_WORDS 3456
#define XB_SPIN_CAP (1u << 18)

__device__ __forceinline__ unsigned xb_ld(unsigned* p)              { return __hip_atomic_load(p, __ATOMIC_RELAXED, __HIP_MEMORY_SCOPE_AGENT); }
__device__ __forceinline__ unsigned xb_add(unsigned* p, unsigned v) { return __hip_atomic_fetch_add(p, v, __ATOMIC_RELAXED, __HIP_MEMORY_SCOPE_AGENT); }
__device__ __forceinline__ unsigned xb_xcc_id() { return (unsigned)__builtin_amdgcn_s_getreg((3 << 11) | 20) & 0xFu; }
#define XB_SPIN(cond, bar) do { unsigned _sp = 0; while (cond) { __builtin_amdgcn_s_sleep(1); \
    if ((++_sp & 255u) == 0u) { if (xb_ld(&(bar)[XB_TMO])) break; if (_sp > XB_SPIN_CAP) { atomicAdd(&(bar)[XB_TMO], 1u); break; } } } } while (0)

struct XcdBarrier {
    unsigned* bar; unsigned x;
    volatile LAS unsigned* st;
};

__device__ __forceinline__ XcdBarrier xcd_barrier_post(unsigned* bar, volatile LAS unsigned* st) {
    XcdBarrier b; b.bar = bar; b.x = xb_xcc_id(); b.st = st;
    if (threadIdx.x == 0) (void)xb_add(&bar[XB_XCNT(b.x)], 1u);
    return b;
}
__device__ __forceinline__ void xcd_barrier_complete(unsigned* bar, unsigned x, unsigned& nloc, unsigned& nx) {
    const unsigned G = gridDim.x * gridDim.y * gridDim.z;
    unsigned sum, cnt, mine, sp = 0u;
    for (;;) {
        sum = 0u; cnt = 0u; mine = 0u;
#pragma unroll
        for (unsigned j = 0; j < 16; ++j) { const unsigned c = xb_ld(&bar[XB_XCNT(j)]); sum += c; cnt += (c > 0u) ? 1u : 0u; mine = (j == x) ? c : mine; }
        if (sum == G) break;
        __builtin_amdgcn_s_sleep(1);
        if ((++sp & 255u) == 0u) { if (xb_ld(&bar[XB_TMO])) break; if (sp > XB_SPIN_CAP) { atomicAdd(&bar[XB_TMO], 1u); break; } }
    }
    nloc = mine > 0u ? mine : 1u; nx = cnt > 0u ? cnt : 1u;
}

__device__ __forceinline__ void xcd_barrier(const XcdBarrier& b) {
    asm volatile("s_waitcnt vmcnt(0)" ::: "memory");
    __syncthreads();
    if (threadIdx.x == 0) {
        unsigned* bar = b.bar;
        __builtin_amdgcn_s_waitcnt(0);
        unsigned nloc = b.st[0], nx = b.st[1];
        if (nloc == 0u) { xcd_barrier_complete(bar, b.x, nloc, nx); b.st[0] = nloc; b.st[1] = nx; }
        const unsigned old = xb_add(&bar[XB_XSUB(b.x)], 1u);
        const unsigned gen = old / nloc;
        if (old + 1u == (gen + 1u) * nloc) {
            __builtin_amdgcn_fence(__ATOMIC_RELEASE, "agent");
            asm volatile("s_waitcnt vmcnt(0)" ::: "memory");
            const unsigned og = xb_add(&bar[XB_TOP], 1u);
            const unsigned tg = og / nx;
            if (og + 1u == (tg + 1u) * nx) xb_add(&bar[XB_TOPGEN], 1u);
            else XB_SPIN(xb_ld(&bar[XB_TOPGEN]) == tg, bar);
            __builtin_amdgcn_fence(__ATOMIC_ACQUIRE, "agent");
            xb_add(&bar[XB_XGEN(b.x)], 1u);
            asm volatile("s_waitcnt vmcnt(0)" ::: "memory");
        } else {
            XB_SPIN(xb_ld(&bar[XB_XGEN(b.x)]) == gen, bar);
            __builtin_amdgcn_fence(__ATOMIC_ACQUIRE, "agent");
            asm volatile("s_waitcnt vmcnt(0)" ::: "memory");
        }
    }
    __syncthreads();
}
constexpr int NWAVES = 8, NTHR = 512;
constexpr int T = 32768, SEQ = 2048, NBATCH = 16, D = 1024;
constexpr int NPROJ = 6656, INW = 6672;
constexpr float EPS = 1e-6f;
constexpr size_t MiB = 1u << 20;
constexpr size_t WS_CTL = 0, CTL_ZERO_BYTES = 64 * 1024;
constexpr size_t WS_GLR = 1 * MiB, WS_ROPE = 3 * MiB, WS_WIN = 4 * MiB, WS_WA = 18 * MiB, WS_WB = 20 * MiB, WS_WO = 22 * MiB, WS_WPQ = 24 * MiB, WS_SUBK = 28 * MiB;
constexpr size_t WS_H = 32 * MiB, WS_U = 32 * MiB, WS_V = 64 * MiB;
constexpr size_t WS_GQ = 96 * MiB, WS_GK = 128 * MiB, WS_GV = 160 * MiB, WS_GR = 224 * MiB, WS_SQ = 288 * MiB, WS_SK = 352 * MiB, WS_SV = 368 * MiB, WS_GA = 384 * MiB, WS_GB = 448 * MiB;
constexpr size_t WS_YA = 96 * MiB, WS_XN2 = 160 * MiB, WS_QP = 224 * MiB, WS_IDX = 352 * MiB, WS_GATE = 368 * MiB, WS_END = 512 * MiB;
constexpr int CW_BAR = 1024;
constexpr int LDS_BYTES = 163840, MISC_OFF = LDS_BYTES - 256;

typedef unsigned long long u64;
typedef float f32x16 __attribute__((ext_vector_type(16)));
typedef __bf16 bf2_t __attribute__((ext_vector_type(2)));
typedef LAS unsigned char* ldsp;

__device__ __forceinline__ float bf_lo(unsigned u) { return __builtin_bit_cast(float, u << 16); }
__device__ __forceinline__ float bf_hi(unsigned u) { return __builtin_bit_cast(float, u & 0xffff0000u); }
#define WS_DPP(x, ctrl, rm) __builtin_bit_cast(float, __builtin_amdgcn_update_dpp(0, __builtin_bit_cast(int, (x)), (ctrl), (rm), 0xf, false))
__device__ __forceinline__ float wave_sum(float v) {
    v += WS_DPP(v, 0x111, 0xf); v += WS_DPP(v, 0x112, 0xf); v += WS_DPP(v, 0x114, 0xf); v += WS_DPP(v, 0x118, 0xf);
    v += WS_DPP(v, 0x142, 0xa); v += WS_DPP(v, 0x143, 0xc);
    return __builtin_bit_cast(float, __builtin_amdgcn_readlane(__builtin_bit_cast(int, v), 63));
}
__device__ __forceinline__ float sigmoidf_(float x) { return 1.f / (1.f + __expf(-x)); }
__device__ __forceinline__ float logsigmoidf_(float z) { return fminf(z, 0.f) - __logf(1.f + __expf(-fabsf(z))); }

struct Frame {
    ldsp lds;
    unsigned char* ws; float* out;
    const float* in[17];
    int tid, lane, wave, vcu, G;
};

__device__ __forceinline__ void transpose_item(const float* W, int ldw, int src_col0, int valid_cols, int K, bf16* WT, int dst_row0, int nblk, LAS float* scr, int item, int lane) {
    const int kb = item / nblk, nb = item % nblk, k0 = 64 * kb, n0 = 32 * nb;
    const int nl = n0 + (lane & 31);
#pragma unroll 8
    for (int i = 0; i < 32; ++i) { const int kk = 2 * i + (lane >> 5); scr[kk * 33 + (lane & 31)] = (nl < valid_cols) ? W[(size_t)(k0 + kk) * ldw + src_col0 + nl] : 0.f; }
    LDS_WAIT(); asm volatile("" ::: "memory");
    const int c = lane & 7;
#pragma unroll
    for (int j = 0; j < 4; ++j) { const int n = (lane >> 3) + 8 * j; const LAS float* s = scr + (8 * c) * 33 + n;
        v4u o; o.x = pk2(s[0 * 33], s[1 * 33]); o.y = pk2(s[2 * 33], s[3 * 33]); o.z = pk2(s[4 * 33], s[5 * 33]); o.w = pk2(s[6 * 33], s[7 * 33]);
        *(GAS v4u*)(WT + (size_t)(dst_row0 + n0 + n) * K + k0 + 8 * c) = o; }
    LDS_WAIT(); asm volatile("" ::: "memory");
}
__device__ __forceinline__ void rms_row_to_bf16(int lane, const float* xrow, const float* g, bf16* orow) {
    const f32x4* xr = (const f32x4*)xrow + lane; const f32x4* gr = (const f32x4*)g + lane;
    f32x4 v[4]; float s = 0.f;
#pragma unroll
    for (int j = 0; j < 4; ++j) { v[j] = xr[64 * j]; s += (v[j].x * v[j].x + v[j].y * v[j].y) + (v[j].z * v[j].z + v[j].w * v[j].w); }
    const float rstd = 1.f / sqrtf(wave_sum(s) * (1.f / D) + EPS);
    u64* o8 = (u64*)orow + lane;
#pragma unroll
    for (int j = 0; j < 4; ++j) { const f32x4 gg = gr[64 * j];
        o8[64 * j] = (u64)pk2(v[j].x * rstd * gg.x, v[j].y * rstd * gg.y) | ((u64)pk2(v[j].z * rstd * gg.z, v[j].w * rstd * gg.w) << 32); }
}
__device__ __forceinline__ int r16_of_lane(int lane) { return ((lane >> 5) & 1) * 8 + ((lane >> 4) & 1) * 4 + ((lane >> 3) & 1) * 2 + ((lane >> 2) & 1); }
__device__ __forceinline__ float reduce16_t(const float* p, int lane) {
    float a[8], b[4], c[2];
    const bool h5 = (lane & 32) != 0, h4 = (lane & 16) != 0, h3 = (lane & 8) != 0, h2 = (lane & 4) != 0;
#pragma unroll
    for (int k = 0; k < 8; ++k) { const float keep = h5 ? p[k + 8] : p[k], send = h5 ? p[k] : p[k + 8]; a[k] = keep + __shfl_xor(send, 32); }
#pragma unroll
    for (int k = 0; k < 4; ++k) { const float keep = h4 ? a[k + 4] : a[k], send = h4 ? a[k] : a[k + 4]; b[k] = keep + __shfl_xor(send, 16); }
#pragma unroll
    for (int k = 0; k < 2; ++k) { const float keep = h3 ? b[k + 2] : b[k], send = h3 ? b[k] : b[k + 2]; c[k] = keep + __shfl_xor(send, 8); }
    float d = (h2 ? c[1] : c[0]) + __shfl_xor(h2 ? c[0] : c[1], 4);
    d += __shfl_xor(d, 2); d += __shfl_xor(d, 1);
    return d;
}
__device__ __forceinline__ void rms_row_glr(int lane, const float* xrow, const float* g, bf16* orow, const LAS float* WG, float* glr_out) {
    const f32x4* xr = (const f32x4*)xrow + lane; const f32x4* gr = (const f32x4*)g + lane;
    f32x4 v[4]; float s = 0.f;
#pragma unroll
    for (int j = 0; j < 4; ++j) { v[j] = xr[64 * j]; s += (v[j].x * v[j].x + v[j].y * v[j].y) + (v[j].z * v[j].z + v[j].w * v[j].w); }
    const float rstd = 1.f / sqrtf(wave_sum(s) * (1.f / D) + EPS);
    u64* o8 = (u64*)orow + lane;
#pragma unroll
    for (int j = 0; j < 4; ++j) { const f32x4 gg = gr[64 * j]; v[j].x *= rstd * gg.x; v[j].y *= rstd * gg.y; v[j].z *= rstd * gg.z; v[j].w *= rstd * gg.w;
        o8[64 * j] = (u64)pk2(v[j].x, v[j].y) | ((u64)pk2(v[j].z, v[j].w) << 32); }
    float p[16];
#pragma unroll
    for (int r = 0; r < 16; ++r) { float a = 0.f;
#pragma unroll
        for (int j = 0; j < 4; ++j) { const f32x4 wv = *(const LAS f32x4*)(WG + r * 1024 + 4 * lane + 256 * j); a += (v[j].x * wv.x + v[j].y * wv.y) + (v[j].z * wv.z + v[j].w * wv.w); }
        p[r] = a; if ((r & 3) == 3) __builtin_amdgcn_sched_barrier(0); }
    const float tot = reduce16_t(p, lane);
    if ((lane & 3) == 0) glr_out[r16_of_lane(lane)] = tot;
}
__device__ __forceinline__ void cvt_rows_bf16(const float* src, bf16* dst, size_t n8, size_t gtid, size_t gthreads) {
    for (size_t i = gtid; i < n8; i += gthreads) { const f32x4 a = ((const f32x4*)src)[2 * i], b = ((const f32x4*)src)[2 * i + 1];
        v4u o; o.x = pk2(a.x, a.y); o.y = pk2(a.z, a.w); o.z = pk2(b.x, b.y); o.w = pk2(b.z, b.w); ((v4u*)dst)[i] = o; }
}
__device__ __forceinline__ void p0_prologue(Frame& F) {
    LAS float* scr = (LAS float*)(F.lds + F.wave * 16384);
    const int gw = F.vcu * NWAVES + F.wave, NGW = F.G * NWAVES;
    const float* w_in = F.in[2];
    constexpr int I1 = 16 * 96, I2 = 16 * 112, I4 = 16 * 32, I7 = 16 * 64;
    constexpr int NITEMS = I1 + I2 + 3 * I4 + I7;
    for (int it = gw; it < NITEMS; it += NGW) {
        int r = it;
        if (r < I1) { transpose_item(w_in, INW, 0, 3072, D, (bf16*)(F.ws + WS_WIN), 0, 96, scr, r, F.lane); continue; } r -= I1;
        if (r < I2) { transpose_item(w_in, INW, 3088, 3584, D, (bf16*)(F.ws + WS_WIN), 3072, 112, scr, r, F.lane); continue; } r -= I2;
        if (r < I4) { transpose_item(F.in[9], D, 0, D, D, (bf16*)(F.ws + WS_WA), 0, 32, scr, r, F.lane); continue; } r -= I4;
        if (r < I4) { transpose_item(F.in[10], D, 0, D, D, (bf16*)(F.ws + WS_WB), 0, 32, scr, r, F.lane); continue; } r -= I4;
        if (r < I4) { transpose_item(F.in[11], D, 0, D, D, (bf16*)(F.ws + WS_WO), 0, 32, scr, r, F.lane); continue; } r -= I4;
        transpose_item(F.in[13], 2048, 0, 2048, D, (bf16*)(F.ws + WS_WPQ), 0, 64, scr, r, F.lane);
    }
    __syncthreads();
    { LAS float* WG = (LAS float*)F.lds;
      for (int i = F.tid; i < 16 * 1024; i += NTHR) { const int k = i >> 4, r = i & 15; WG[r * 1024 + k] = w_in[(size_t)k * INW + 3072 + r]; }
      __syncthreads();
      for (int m = gw; m < T; m += NGW) rms_row_glr(F.lane, F.in[0] + (size_t)m * D, F.in[1], (bf16*)(F.ws + WS_H) + (size_t)m * D, WG, (float*)(F.ws + WS_GLR) + (size_t)m * 16); }
    const size_t gtid = (size_t)F.vcu * NTHR + F.tid, gthreads = (size_t)F.G * NTHR;
    cvt_rows_bf16(F.in[14], (bf16*)(F.ws + WS_SUBK), (size_t)(8 * 2 * 128 * 128) / 8, gtid, gthreads);
    if (gtid < (size_t)SEQ * 8) {
        const double invf[8] = {1.0, 0.19392274474868576, 0.03760603093086393, 0.007292664737217109, 0.001414213562373095, 0.0002742481756762073, 5.318295896944988e-05, 1.031338537721246e-05};
        const int pos = (int)(gtid >> 3), j = (int)(gtid & 7);
        double iv = invf[0];
#pragma unroll
        for (int q = 1; q < 8; ++q) iv = (j == q) ? invf[q] : iv;
        const float angf = (float)pos * (float)iv;
        const double rev = (double)angf * 0.15915494309189535;
        const double fr = rev - floor(rev);
        const float f = (float)fr;
        float2 cs; cs.x = __builtin_amdgcn_cosf(f); cs.y = __builtin_amdgcn_sinf(f);
        ((float2*)(F.ws + WS_ROPE))[gtid] = cs;
    }
}
template <int MODE> struct EpiB {
    static constexpr bool PERM = true, AFTER_DRAIN = false;
    unsigned char* ws;
    __device__ __forceinline__ void operator()(const pg8::f32x4 (&acc)[2][2][4][2], const pg8::Unit& u, int wr, int wc, int fr, int fq) const {
        using namespace pg8;
        const int row0 = u.pm * BM + wr * 64 + fr;
        bf16_t* base; int ldc, colt, act = 0; const bf16_t* gate = nullptr;
        if (MODE == 0) {
            const int pn = u.pn;
            if (pn == 26) {
                if (wc == 0 && fq < 2) { float* G = (float*)(ws + WS_GLR);
#pragma unroll
                    for (int ai = 0; ai < 2; ++ai)
#pragma unroll
                        for (int m = 0; m < 4; ++m) { float* rp = G + (size_t)(row0 + ai * HALF + m * 16) * 16 + 8 * fq; *(f32x4*)rp = acc[ai][0][m][0]; *(f32x4*)(rp + 4) = acc[ai][0][m][1]; } }
                return;
            }
            size_t off;
            if (pn < 2) { off = WS_GQ; ldc = 512; colt = pn * 256; }
            else if (pn < 4) { off = WS_GK; ldc = 512; colt = (pn - 2) * 256; }
            else if (pn < 8) { off = WS_GV; ldc = 1024; colt = (pn - 4) * 256; }
            else if (pn < 12) { off = WS_GR; ldc = 1024; colt = (pn - 8) * 256; act = 1; }
            else if (pn < 16) { off = WS_SQ; ldc = 1024; colt = (pn - 12) * 256; }
            else if (pn < 17) { off = WS_SK; ldc = 256; colt = 0; }
            else if (pn < 18) { off = WS_SV; ldc = 256; colt = 0; }
            else if (pn < 22) { off = WS_GA; ldc = 1024; colt = (pn - 18) * 256; act = 2; }
            else { off = WS_GB; ldc = 1024; colt = (pn - 22) * 256; act = 2; }
            base = (bf16_t*)(ws + off);
        } else if (MODE == 1) { base = (bf16_t*)(ws + WS_YA); ldc = 1024; colt = u.pn * BM; gate = (const bf16_t*)(ws + WS_GA); }
        else if (MODE == 2) { base = (bf16_t*)(ws + WS_YA); ldc = 1024; colt = u.pn * BM; gate = (const bf16_t*)(ws + WS_GB); }
        else { base = (bf16_t*)(ws + WS_QP); ldc = 2048; colt = u.pn * BM; }
        const int col0 = colt + wc * 32 + 8 * fq;
#pragma unroll
        for (int ai = 0; ai < 2; ++ai)
#pragma unroll
            for (int m = 0; m < 4; ++m) { const size_t ro = (size_t)(row0 + ai * HALF + m * 16) * ldc + col0;
#pragma unroll
                for (int bj = 0; bj < 2; ++bj) { f32x4 v0 = acc[ai][bj][m][0], v1 = acc[ai][bj][m][1];
                    if (MODE == 0) {
                        if (act == 1) {
#pragma unroll
                            for (int e = 0; e < 4; ++e) { v0[e] = v0[e] * sigmoidf_(v0[e]); v1[e] = v1[e] * sigmoidf_(v1[e]); } }
                        else if (act == 2) {
#pragma unroll
                            for (int e = 0; e < 4; ++e) { v0[e] = sigmoidf_(v0[e]); v1[e] = sigmoidf_(v1[e]); } }
                    }
                    if (MODE == 1 || MODE == 2) {
                        const u32x4 gv = *(const u32x4*)(gate + ro + bj * HALF);
                        v0[0] *= bf_lo(gv.x); v0[1] *= bf_hi(gv.x); v0[2] *= bf_lo(gv.y); v0[3] *= bf_hi(gv.y);
                        v1[0] *= bf_lo(gv.z); v1[1] *= bf_hi(gv.z); v1[2] *= bf_lo(gv.w); v1[3] *= bf_hi(gv.w);
                        if (MODE == 2) { const u32x4 yv = *(const u32x4*)(base + ro + bj * HALF);
                            v0[0] += bf_lo(yv.x); v0[1] += bf_hi(yv.x); v0[2] += bf_lo(yv.y); v0[3] += bf_hi(yv.y);
                            v1[0] += bf_lo(yv.z); v1[1] += bf_hi(yv.z); v1[2] += bf_lo(yv.w); v1[3] += bf_hi(yv.w); }
                    }
                    u32x4 w; w.x = cvt_pk_bf16(v0[0], v0[1]); w.y = cvt_pk_bf16(v0[2], v0[3]); w.z = cvt_pk_bf16(v1[0], v1[1]); w.w = cvt_pk_bf16(v1[2], v1[3]);
                    *(u32x4*)(base + ro + bj * HALF) = w; } }
    }
};
struct EpiX1 {
    static constexpr bool PERM = false, AFTER_DRAIN = false;
    const float* x; float* out;
    __device__ __forceinline__ void operator()(const pg8::f32x4 (&acc)[2][2][4][2], const pg8::Unit& u, int wr, int wc, int fr, int fq) const {
        using namespace pg8;
        const int row0 = u.pm * BM + wr * 64 + fr, col0 = u.pn * BM + wc * 32 + 4 * fq;
#pragma unroll
        for (int ai = 0; ai < 2; ++ai)
#pragma unroll
            for (int m = 0; m < 4; ++m) { const size_t ro = (size_t)(row0 + ai * HALF + m * 16) * D + col0;
#pragma unroll
                for (int bj = 0; bj < 2; ++bj)
#pragma unroll
                    for (int n = 0; n < 2; ++n) { const size_t o = ro + bj * HALF + n * 16; *(f32x4*)(out + o) = *(const f32x4*)(x + o) + acc[ai][bj][m][n]; } }
    }
};
constexpr int GL_QT = 0, GL_KT = 17408, GL_KTT = 34816, GL_VT = 53248, GL_ATT = 90112, GL_BC = 99328, GL_SEG = 132096, GL_EREF = 134144, GL_ELAST = 134656, GL_GLR = 135168, GL_END = 139264;
constexpr int GL_OST = 0;
static_assert(GL_END <= MISC_OFF, "gla lds");
__device__ __forceinline__ pg8::bf16x8 mk8(u64 lo, u64 hi) { pg8::u32x4 v; v.x = (unsigned)lo; v.y = (unsigned)(lo >> 32); v.z = (unsigned)hi; v.w = (unsigned)(hi >> 32); return __builtin_bit_cast(pg8::bf16x8, v); }
#define LBAR() do { asm volatile("s_waitcnt lgkmcnt(0)" ::: "memory"); __builtin_amdgcn_s_barrier(); asm volatile("" ::: "memory"); } while (0)
constexpr size_t WS_EG = WS_WIN;
struct PreRegs { pg8::u32x4 q0, q1, k0, k1, v0a, v0b, v1a, v1b; pg8::f32x4 gl; };
__device__ __forceinline__ void gla_pre_load(Frame& F, int u, PreRegs& r) {
    using pg8::u32x4; using pg8::f32x4;
    const int b = u >> 7, h = (u >> 5) & 3, n = u & 31, tid = F.tid, tp = tid >> 4, dg = tid & 15, t0 = 2 * tp, d0 = 8 * dg, e0 = 16 * dg;
    const size_t rowbase = (size_t)b * SEQ + n * 64;
    const bf16* qp0 = (const bf16*)(F.ws + WS_GQ) + (rowbase + t0) * 512 + h * 128 + d0; const bf16* kp0 = (const bf16*)(F.ws + WS_GK) + (rowbase + t0) * 512 + h * 128 + d0;
    const bf16* GV = (const bf16*)(F.ws + WS_GV);
    r.q0 = *(const u32x4*)qp0; r.q1 = *(const u32x4*)(qp0 + 512); r.k0 = *(const u32x4*)kp0; r.k1 = *(const u32x4*)(kp0 + 512);
    r.v0a = *(const u32x4*)(GV + (rowbase + t0) * 1024 + h * 256 + e0); r.v0b = *(const u32x4*)(GV + (rowbase + t0) * 1024 + h * 256 + e0 + 8);
    r.v1a = *(const u32x4*)(GV + (rowbase + t0 + 1) * 1024 + h * 256 + e0); r.v1b = *(const u32x4*)(GV + (rowbase + t0 + 1) * 1024 + h * 256 + e0 + 8);
    if (tid < 256) r.gl = *(const f32x4*)((const float*)(F.ws + WS_GLR) + (rowbase + (tid >> 2)) * 16 + (tid & 3) * 4);
}
__device__ __forceinline__ void gla_pre_unit(Frame& F, int b, int h, int n, const PreRegs& R) {
    using pg8::u32x4; using pg8::f32x4;
    const ldsp L = F.lds; const int tid = F.tid;
    bf16* GQ = (bf16*)(F.ws + WS_GQ); bf16* GK = (bf16*)(F.ws + WS_GK); const float* GLR = (const float*)(F.ws + WS_GLR);
    float* EG = (float*)(F.ws + WS_EG) + (size_t)((b * 4 + h) * 32 + n) * 256;
    const float* w2 = F.in[3]; const float* bgk = F.in[4];
    const int dch = tid & 127, sg = tid >> 7;
    float w2c[16];
#pragma unroll
    for (int r = 0; r < 16; ++r) w2c[r] = w2[r * 512 + h * 128 + dch];
    const float bias = bgk[h * 128 + dch];
    const int tp = tid >> 4, dg = tid & 15, t0 = 2 * tp, d0 = 8 * dg;
    const float qscale = 0.08838834764831845f;
    const size_t rowbase = (size_t)b * SEQ + n * 64;
    bf16* qp0 = GQ + (rowbase + t0) * 512 + h * 128 + d0; bf16* kp0 = GK + (rowbase + t0) * 512 + h * 128 + d0;
    const u32x4 q0 = R.q0, q1 = R.q1, k0 = R.k0, k1 = R.k1, v0a = R.v0a, v0b = R.v0b, v1a = R.v1a, v1b = R.v1b; const int e0 = 16 * dg;
    (void)GLR;
    if (tid < 256) { *(LAS f32x4*)(L + GL_GLR + tid * 16) = R.gl; }
    LBAR();
    {
        float run = 0.f;
#pragma unroll 4
        for (int tt = 0; tt < 16; ++tt) { const int t = 16 * sg + tt; const LAS float* gl = (const LAS float*)(L + GL_GLR + t * 64);
            float z = bias;
#pragma unroll
            for (int r = 0; r < 16; ++r) z += gl[r] * w2c[r];
            run += logsigmoidf_(z) * (1.f / 16.f);
            ((LAS float*)(L + GL_BC))[t * 128 + dch] = run; }
        ((LAS float*)(L + GL_SEG))[sg * 128 + dch] = run;
    }
    LBAR();
    {
        const LAS float* BC = (const LAS float*)(L + GL_BC); const LAS float* SG = (const LAS float*)(L + GL_SEG);
        const int sgt = t0 >> 4;
        float qs0[8], qs1[8], ks0[8], ks1[8];
        const unsigned qa[4] = {q0.x, q0.y, q0.z, q0.w}, qb[4] = {q1.x, q1.y, q1.z, q1.w}, ka[4] = {k0.x, k0.y, k0.z, k0.w}, kb[4] = {k1.x, k1.y, k1.z, k1.w};
#pragma unroll
        for (int j = 0; j < 8; ++j) { const int d = d0 + j;
            const float s0 = SG[d], s1 = SG[128 + d], s2 = SG[256 + d];
            const float pre = (sgt > 0 ? s0 : 0.f) + (sgt > 1 ? s1 : 0.f) + (sgt > 2 ? s2 : 0.f);
            const float bref = BC[32 * 128 + d] + s0 + s1;
            const float b0 = BC[t0 * 128 + d] + pre - bref, b1 = BC[(t0 + 1) * 128 + d] + pre - bref;
            const float e0q = __expf(b0), e1q = __expf(b1), e0k = __expf(-b0), e1k = __expf(-b1);
            const float qv0 = (j & 1) ? bf_hi(qa[j >> 1]) : bf_lo(qa[j >> 1]), qv1 = (j & 1) ? bf_hi(qb[j >> 1]) : bf_lo(qb[j >> 1]);
            const float kv0 = (j & 1) ? bf_hi(ka[j >> 1]) : bf_lo(ka[j >> 1]), kv1 = (j & 1) ? bf_hi(kb[j >> 1]) : bf_lo(kb[j >> 1]);
            qs0[j] = qv0 * qscale * e0q; qs1[j] = qv1 * qscale * e1q; ks0[j] = kv0 * e0k; ks1[j] = kv1 * e1k; }
        u32x4 o;
        o.x = pk2(qs0[0], qs0[1]); o.y = pk2(qs0[2], qs0[3]); o.z = pk2(qs0[4], qs0[5]); o.w = pk2(qs0[6], qs0[7]); *(u32x4*)qp0 = o; *(LAS u32x4*)(L + GL_QT + t0 * 272 + d0 * 2) = o;
        o.x = pk2(qs1[0], qs1[1]); o.y = pk2(qs1[2], qs1[3]); o.z = pk2(qs1[4], qs1[5]); o.w = pk2(qs1[6], qs1[7]); *(u32x4*)(qp0 + 512) = o; *(LAS u32x4*)(L + GL_QT + (t0 + 1) * 272 + d0 * 2) = o;
        o.x = pk2(ks0[0], ks0[1]); o.y = pk2(ks0[2], ks0[3]); o.z = pk2(ks0[4], ks0[5]); o.w = pk2(ks0[6], ks0[7]); *(u32x4*)kp0 = o; *(LAS u32x4*)(L + GL_KT + t0 * 272 + d0 * 2) = o;
        o.x = pk2(ks1[0], ks1[1]); o.y = pk2(ks1[2], ks1[3]); o.z = pk2(ks1[4], ks1[5]); o.w = pk2(ks1[6], ks1[7]); *(u32x4*)(kp0 + 512) = o; *(LAS u32x4*)(L + GL_KT + (t0 + 1) * 272 + d0 * 2) = o;
        { const unsigned va[8] = {v0a.x, v0a.y, v0a.z, v0a.w, v0b.x, v0b.y, v0b.z, v0b.w}, vb[8] = {v1a.x, v1a.y, v1a.z, v1a.w, v1b.x, v1b.y, v1b.z, v1b.w};
#pragma unroll
          for (int j = 0; j < 16; ++j) { const unsigned a = va[j >> 1], c = vb[j >> 1];
              const unsigned pk = (j & 1) ? ((a >> 16) | (c & 0xffff0000u)) : ((a & 0xffffu) | (c << 16));
              *(LAS unsigned*)(L + GL_VT + (e0 + j) * 144 + (((tp >> 2) ^ (dg & 7)) << 4) + ((tp & 3) << 2)) = pk; } }
        if (tid < 128) { const int d = tid; const float s0 = SG[d], s1 = SG[128 + d], s2 = SG[256 + d];
            const float bref = BC[32 * 128 + d] + s0 + s1, blast = BC[63 * 128 + d] + s0 + s1 + s2;
            EG[d] = __expf(bref); EG[128 + d] = __expf(blast - bref); }
    }
    LBAR();
    {
        using pg8::bf16x8; const int lane = F.lane, w = F.wave, l16 = lane & 15, g4 = lane >> 4; const int tt4 = w >> 1;
#pragma unroll
        for (int q = 0; q < 2; ++q) { const int st4 = 2 * (w & 1) + q; f32x4 a4 = {0.f, 0.f, 0.f, 0.f};
#pragma unroll
            for (int ks = 0; ks < 4; ++ks) { const bf16x8 A = *(const LAS bf16x8*)(L + GL_QT + (16 * tt4 + l16) * 272 + (32 * ks + 8 * g4) * 2), Bk = *(const LAS bf16x8*)(L + GL_KT + (16 * st4 + l16) * 272 + (32 * ks + 8 * g4) * 2);
                a4 = __builtin_amdgcn_mfma_f32_16x16x32_bf16(A, Bk, a4, 0, 0, 0); }
#pragma unroll
            for (int i = 0; i < 4; ++i) { const int t = 16 * tt4 + 4 * g4 + i, s_ = 16 * st4 + l16; const float v = (s_ <= t) ? a4[i] : 0.f;
                *(LAS unsigned short*)(L + GL_ATT + t * 144 + s_ * 2) = (unsigned short)f2bf(v); } }
    }
    LBAR();
    {
        using pg8::bf16x8; const int lane = F.lane, w = F.wave, hb = lane >> 5, l32 = lane & 31;
        f32x16 oacc[2];
#pragma unroll
        for (int i = 0; i < 16; ++i) { oacc[0][i] = 0.f; oacc[1][i] = 0.f; }
#pragma unroll
        for (int ks = 0; ks < 4; ++ks) { const bf16x8 Bv = *(const LAS bf16x8*)(L + GL_VT + (32 * w + l32) * 144 + (((2 * ks + hb) ^ (((32 * w + l32) >> 4) & 7)) << 4));
#pragma unroll
            for (int tt = 0; tt < 2; ++tt) { const bf16x8 A = *(const LAS bf16x8*)(L + GL_ATT + (32 * tt + l32) * 144 + (16 * ks + 8 * hb) * 2);
                oacc[tt] = __builtin_amdgcn_mfma_f32_32x32x16_bf16(A, Bv, oacc[tt], 0, 0, 0); } }
        const int P = w * 64 + lane; bf16* pp = (bf16*)F.out + (rowbase + (P >> 3)) * 1024 + h * 256 + (P & 7) * 32;
#pragma unroll
        for (int tt = 0; tt < 2; ++tt)
#pragma unroll
            for (int c = 0; c < 2; ++c) { u32x4 o; o.x = pk2(oacc[tt][8 * c + 0], oacc[tt][8 * c + 1]); o.y = pk2(oacc[tt][8 * c + 2], oacc[tt][8 * c + 3]); o.z = pk2(oacc[tt][8 * c + 4], oacc[tt][8 * c + 5]); o.w = pk2(oacc[tt][8 * c + 6], oacc[tt][8 * c + 7]);
                *(u32x4*)(pp + 16 * tt + 8 * c) = o; }
    }
}
__device__ __forceinline__ void gla_unit(Frame& F, int b, int h) {
    using pg8::bf16x8; using pg8::u32x4; using pg8::f32x4;
    const ldsp L = F.lds; const int tid = F.tid, lane = F.lane, w = F.wave, hb = lane >> 5, l32 = lane & 31;
    const bf16* GQ = (const bf16*)(F.ws + WS_GQ); const bf16* GK = (const bf16*)(F.ws + WS_GK); const bf16* GV = (const bf16*)(F.ws + WS_GV);
    const float* EG = (const float*)(F.ws + WS_EG) + (size_t)((b * 4 + h) * 32) * 256; bf16* OA = (bf16*)F.out;
    f32x16 st[4];
#pragma unroll
    for (int dt = 0; dt < 4; ++dt)
#pragma unroll
        for (int i = 0; i < 16; ++i) st[dt][i] = 0.f;
    const int tp = tid >> 4, dg = tid & 15, t0 = 2 * tp, d0 = 8 * dg, e0 = 16 * dg;
    const int P = w * 64 + lane;
    u32x4 q0, q1, k0, k1, v0a, v0b, v1a, v1b, oi[4]; float egv = 0.f;
#define GLA_PREFETCH(nn) do { const size_t rb_ = (size_t)b * SEQ + (nn) * 64; \
        q0 = *(const u32x4*)(GQ + (rb_ + t0) * 512 + h * 128 + d0); q1 = *(const u32x4*)(GQ + (rb_ + t0 + 1) * 512 + h * 128 + d0); \
        k0 = *(const u32x4*)(GK + (rb_ + t0) * 512 + h * 128 + d0); k1 = *(const u32x4*)(GK + (rb_ + t0 + 1) * 512 + h * 128 + d0); \
        v0a = *(const u32x4*)(GV + (rb_ + t0) * 1024 + h * 256 + e0); v0b = *(const u32x4*)(GV + (rb_ + t0) * 1024 + h * 256 + e0 + 8); \
        v1a = *(const u32x4*)(GV + (rb_ + t0 + 1) * 1024 + h * 256 + e0); v1b = *(const u32x4*)(GV + (rb_ + t0 + 1) * 1024 + h * 256 + e0 + 8); \
        { const u32x4* pp_ = (const u32x4*)(OA + (rb_ + (P >> 3)) * 1024 + h * 256 + (P & 7) * 32); oi[0] = pp_[0]; oi[1] = pp_[1]; oi[2] = pp_[2]; oi[3] = pp_[3]; } \
        if (tid < 256) egv = EG[(nn) * 256 + tid]; } while (0)
    GLA_PREFETCH(0);
    for (int n = 0; n < 32; ++n) {
        const size_t rowbase = (size_t)b * SEQ + n * 64;
        LBAR();
        {
            *(LAS u32x4*)(L + GL_QT + t0 * 272 + d0 * 2) = q0; *(LAS u32x4*)(L + GL_QT + (t0 + 1) * 272 + d0 * 2) = q1;
            const unsigned ka[4] = {k0.x, k0.y, k0.z, k0.w}, kb[4] = {k1.x, k1.y, k1.z, k1.w};
#pragma unroll
            for (int j = 0; j < 8; ++j) { const unsigned a = ka[j >> 1], c = kb[j >> 1];
                const unsigned pk = (j & 1) ? ((a >> 16) | (c & 0xffff0000u)) : ((a & 0xffffu) | (c << 16));
                *(LAS unsigned*)(L + GL_KTT + (d0 + j) * 144 + (((tp >> 2) ^ (dg & 7)) << 4) + ((tp & 3) << 2)) = pk; }
            const unsigned va[8] = {v0a.x, v0a.y, v0a.z, v0a.w, v0b.x, v0b.y, v0b.z, v0b.w}, vb[8] = {v1a.x, v1a.y, v1a.z, v1a.w, v1b.x, v1b.y, v1b.z, v1b.w};
#pragma unroll
            for (int j = 0; j < 16; ++j) { const unsigned a = va[j >> 1], c = vb[j >> 1];
                const unsigned pk = (j & 1) ? ((a >> 16) | (c & 0xffff0000u)) : ((a & 0xffffu) | (c << 16));
                *(LAS unsigned*)(L + GL_VT + (e0 + j) * 144 + (((tp >> 2) ^ (dg & 7)) << 4) + ((tp & 3) << 2)) = pk; }
            if (tid < 256) ((LAS float*)(L + GL_EREF))[tid] = egv;
        }
        f32x16 oacc[2];
#pragma unroll
        for (int tt = 0; tt < 2; ++tt)
#pragma unroll
            for (int c = 0; c < 2; ++c) { const u32x4 pv = oi[2 * tt + c];
                oacc[tt][8 * c + 0] = bf_lo(pv.x); oacc[tt][8 * c + 1] = bf_hi(pv.x); oacc[tt][8 * c + 2] = bf_lo(pv.y); oacc[tt][8 * c + 3] = bf_hi(pv.y);
                oacc[tt][8 * c + 4] = bf_lo(pv.z); oacc[tt][8 * c + 5] = bf_hi(pv.z); oacc[tt][8 * c + 6] = bf_lo(pv.w); oacc[tt][8 * c + 7] = bf_hi(pv.w); }
        if (n + 1 < 32) GLA_PREFETCH(n + 1);
        LBAR();
        {
            const LAS float* ER = (const LAS float*)(L + GL_EREF);
#pragma unroll
            for (int dt = 0; dt < 4; ++dt) {
#pragma unroll
                for (int q = 0; q < 4; ++q) { const f32x4 e4 = *(const LAS f32x4*)(ER + 32 * dt + 8 * q + 4 * hb); st[dt][4 * q] *= e4.x; st[dt][4 * q + 1] *= e4.y; st[dt][4 * q + 2] *= e4.z; st[dt][4 * q + 3] *= e4.w; }
#pragma unroll
                for (int ks = 0; ks < 2; ++ks) {
                    u32x4 bb; bb.x = pk2(st[dt][8 * ks + 0], st[dt][8 * ks + 1]); bb.y = pk2(st[dt][8 * ks + 2], st[dt][8 * ks + 3]); bb.z = pk2(st[dt][8 * ks + 4], st[dt][8 * ks + 5]); bb.w = pk2(st[dt][8 * ks + 6], st[dt][8 * ks + 7]);
                    const bf16x8 B = __builtin_bit_cast(bf16x8, bb);
#pragma unroll
                    for (int tt = 0; tt < 2; ++tt) { const int t = 32 * tt + l32; const int dbase = 32 * dt + 16 * ks + 4 * hb;
                        const u64 lo = *(const LAS u64*)(L + GL_QT + t * 272 + dbase * 2), hi = *(const LAS u64*)(L + GL_QT + t * 272 + (dbase + 8) * 2);
                        oacc[tt] = __builtin_amdgcn_mfma_f32_32x32x16_bf16(mk8(lo, hi), B, oacc[tt], 0, 0, 0); }
                }
            }
        }
        { bf16* pp = OA + (rowbase + (P >> 3)) * 1024 + h * 256 + (P & 7) * 32;
#pragma unroll
          for (int tt = 0; tt < 2; ++tt)
#pragma unroll
            for (int c = 0; c < 2; ++c) { u32x4 o; o.x = pk2(oacc[tt][8 * c + 0], oacc[tt][8 * c + 1]); o.y = pk2(oacc[tt][8 * c + 2], oacc[tt][8 * c + 3]); o.z = pk2(oacc[tt][8 * c + 4], oacc[tt][8 * c + 5]); o.w = pk2(oacc[tt][8 * c + 6], oacc[tt][8 * c + 7]);
                *(u32x4*)(pp + 16 * tt + 8 * c) = o; } }
        {
            bf16x8 Bv[4];
#pragma unroll
            for (int ks = 0; ks < 4; ++ks) Bv[ks] = *(const LAS bf16x8*)(L + GL_VT + (32 * w + l32) * 144 + (((2 * ks + hb) ^ (((32 * w + l32) >> 4) & 7)) << 4));
            const LAS float* EL = (const LAS float*)(L + GL_ELAST);
#pragma unroll
            for (int dt = 0; dt < 4; ++dt) {
#pragma unroll
                for (int ks = 0; ks < 4; ++ks) { const bf16x8 A = *(const LAS bf16x8*)(L + GL_KTT + (32 * dt + l32) * 144 + (((2 * ks + hb) ^ (((32 * dt + l32) >> 3) & 7)) << 4));
                    st[dt] = __builtin_amdgcn_mfma_f32_32x32x16_bf16(A, Bv[ks], st[dt], 0, 0, 0); }
#pragma unroll
                for (int q = 0; q < 4; ++q) { const f32x4 e4 = *(const LAS f32x4*)(EL + 32 * dt + 8 * q + 4 * hb); st[dt][4 * q] *= e4.x; st[dt][4 * q + 1] *= e4.y; st[dt][4 * q + 2] *= e4.z; st[dt][4 * q + 3] *= e4.w; }
            }
        }
    }
#undef GLA_PREFETCH
}
__device__ __forceinline__ void gla_post_unit(Frame& F, int b, int h, int n) {
    using pg8::u32x4; using pg8::f32x4;
    const ldsp L = F.lds; const int tid = F.tid, lane = F.lane, w = F.wave, hb = lane >> 5, l32 = lane & 31;
    const bf16* GR = (const bf16*)(F.ws + WS_GR); bf16* OA = (bf16*)F.out; const float* gng = F.in[5];
    const size_t rowbase = (size_t)b * SEQ + n * 64;
    const int P = tid; const u32x4* pp = (const u32x4*)(OA + (rowbase + (P >> 3)) * 1024 + h * 256 + (P & 7) * 32);
    const u32x4 pv[4] = {pp[0], pp[1], pp[2], pp[3]};
    const int et = tid >> 3, ec = tid & 7, ee = 32 * ec;
    u32x4 grv[4];
    { const bf16* grp = GR + (rowbase + et) * 1024 + h * 256 + ee;
#pragma unroll
      for (int j2 = 0; j2 < 4; ++j2) grv[j2] = *(const u32x4*)(grp + 8 * j2); }
    LBAR();
#pragma unroll
    for (int tt = 0; tt < 2; ++tt)
#pragma unroll
        for (int c = 0; c < 2; ++c) { const u32x4 x = pv[2 * tt + c]; const unsigned xs[4] = {x.x, x.y, x.z, x.w};
#pragma unroll
            for (int q = 0; q < 4; ++q) { const int i0 = 8 * c + 2 * q;
                ((LAS float*)(L + GL_OST))[(32 * tt + 8 * (i0 >> 2) + 4 * hb + (i0 & 3)) * 260 + 32 * w + l32] = bf_lo(xs[q]);
                ((LAS float*)(L + GL_OST))[(32 * tt + 8 * ((i0 + 1) >> 2) + 4 * hb + ((i0 + 1) & 3)) * 260 + 32 * w + l32] = bf_hi(xs[q]); } }
    LBAR();
    {
        f32x4 ov[8]; float ss = 0.f;
#pragma unroll
        for (int j = 0; j < 8; ++j) { ov[j] = *(const LAS f32x4*)(L + GL_OST + (et * 260 + ee + 4 * j) * 4); ss += (ov[j].x * ov[j].x + ov[j].y * ov[j].y) + (ov[j].z * ov[j].z + ov[j].w * ov[j].w); }
        ss += __shfl_xor(ss, 1); ss += __shfl_xor(ss, 2); ss += __shfl_xor(ss, 4);
        const float rstd = 1.f / sqrtf(ss * (1.f / 256.f) + EPS);
        bf16* op = OA + (rowbase + et) * 1024 + h * 256 + ee;
#pragma unroll
        for (int j2 = 0; j2 < 4; ++j2) { const u32x4 gv = grv[j2]; const f32x4 g0 = *(const f32x4*)(gng + ee + 8 * j2), g1 = *(const f32x4*)(gng + ee + 8 * j2 + 4);
            const f32x4 a = ov[2 * j2], c2 = ov[2 * j2 + 1]; u32x4 o;
            o.x = pk2(a.x * rstd * g0.x * bf_lo(gv.x), a.y * rstd * g0.y * bf_hi(gv.x)); o.y = pk2(a.z * rstd * g0.z * bf_lo(gv.y), a.w * rstd * g0.w * bf_hi(gv.y));
            o.z = pk2(c2.x * rstd * g1.x * bf_lo(gv.z), c2.y * rstd * g1.y * bf_hi(gv.z)); o.w = pk2(c2.z * rstd * g1.z * bf_lo(gv.w), c2.w * rstd * g1.w * bf_hi(gv.w));
            *(u32x4*)(op + 8 * j2) = o; }
    }
}
constexpr int SW_KS = 0, SW_VT = 36864, SW_QS = 36864 + 33792, SW_END = SW_QS + 18432;
static_assert(SW_END <= MISC_OFF, "swa lds");
__device__ __forceinline__ void swa_unit(Frame& F, int b, int qb, int kvh) {
    using pg8::bf16x8; using pg8::u32x4; using pg8::f32x4;
    const ldsp L = F.lds; const int tid = F.tid, lane = F.lane, w = F.wave, l16 = lane & 15, g4 = lane >> 4;
    const bf16* SQ = (const bf16*)(F.ws + WS_SQ); const bf16* SK = (const bf16*)(F.ws + WS_SK); const bf16* SV = (const bf16*)(F.ws + WS_SV);
    const float2* ROPE = (const float2*)(F.ws + WS_ROPE); bf16* OB = (bf16*)F.out + (size_t)T * D;
    const float* qng = F.in[6]; const float* kng = F.in[7]; const float* sinks = F.in[8];
    __syncthreads();
    {
        const int key = tid >> 1, half = tid & 1; const int pos = (qb - 1) * 128 + key;
        float x[32];
        if (pos >= 0) { const u32x4* src = (const u32x4*)(SK + ((size_t)b * SEQ + pos) * 256 + kvh * 64 + 32 * half);
#pragma unroll
            for (int j = 0; j < 4; ++j) { const u32x4 v = src[j]; x[8 * j + 0] = bf_lo(v.x); x[8 * j + 1] = bf_hi(v.x); x[8 * j + 2] = bf_lo(v.y); x[8 * j + 3] = bf_hi(v.y); x[8 * j + 4] = bf_lo(v.z); x[8 * j + 5] = bf_hi(v.z); x[8 * j + 6] = bf_lo(v.w); x[8 * j + 7] = bf_hi(v.w); } }
        else {
#pragma unroll
            for (int j = 0; j < 32; ++j) x[j] = 0.f; }
        float ss = 0.f;
#pragma unroll
        for (int j = 0; j < 32; ++j) ss += x[j] * x[j];
        ss += __shfl_xor(ss, 1);
        const float rstd = 1.f / sqrtf(ss * (1.f / 64.f) + EPS);
#pragma unroll
        for (int j = 0; j < 32; ++j) x[j] = x[j] * rstd * kng[32 * half + j];
        if (half == 0 && pos >= 0) {
#pragma unroll
            for (int j = 0; j < 8; ++j) { const float2 cs = ROPE[pos * 8 + j]; const float a = x[j], c = x[8 + j]; x[j] = a * cs.x - c * cs.y; x[8 + j] = c * cs.x + a * cs.y; } }
#pragma unroll
        for (int j = 0; j < 4; ++j) { u32x4 o; o.x = pk2(x[8 * j], x[8 * j + 1]); o.y = pk2(x[8 * j + 2], x[8 * j + 3]); o.z = pk2(x[8 * j + 4], x[8 * j + 5]); o.w = pk2(x[8 * j + 6], x[8 * j + 7]);
            *(LAS u32x4*)(L + SW_KS + key * 144 + (32 * half + 8 * j) * 2) = o; }
    }
    {
        const int kp = tid >> 2, dq = tid & 3; const int pos0 = (qb - 1) * 128 + 2 * kp;
        u32x4 a0 = {0u, 0u, 0u, 0u}, a1 = a0, c0 = a0, c1 = a0;
        if (pos0 >= 0) { const u32x4* s0 = (const u32x4*)(SV + ((size_t)b * SEQ + pos0) * 256 + kvh * 64 + 16 * dq); const u32x4* s1 = (const u32x4*)(SV + ((size_t)b * SEQ + pos0 + 1) * 256 + kvh * 64 + 16 * dq);
            a0 = s0[0]; a1 = s0[1]; c0 = s1[0]; c1 = s1[1]; }
        const unsigned va[8] = {a0.x, a0.y, a0.z, a0.w, a1.x, a1.y, a1.z, a1.w}, vb[8] = {c0.x, c0.y, c0.z, c0.w, c1.x, c1.y, c1.z, c1.w};
#pragma unroll
        for (int j = 0; j < 16; ++j) { const unsigned a = va[j >> 1], c = vb[j >> 1];
            const unsigned pk = (j & 1) ? ((a >> 16) | (c & 0xffff0000u)) : ((a & 0xffffu) | (c << 16));
            *(LAS unsigned*)(L + SW_VT + (16 * dq + j) * 528 + kp * 4) = pk; }
    }
    for (int gh = 0; gh < 4; ++gh) {
        const int h = kvh * 4 + gh;
        if (gh > 0) __syncthreads();
        {
            const int row = tid >> 2, qq = tid & 3; const int pos = qb * 128 + row;
            const u32x4* src = (const u32x4*)(SQ + ((size_t)b * SEQ + pos) * 1024 + h * 64 + 16 * qq);
            float x[16];
#pragma unroll
            for (int j = 0; j < 2; ++j) { const u32x4 v = src[j]; x[8 * j + 0] = bf_lo(v.x); x[8 * j + 1] = bf_hi(v.x); x[8 * j + 2] = bf_lo(v.y); x[8 * j + 3] = bf_hi(v.y); x[8 * j + 4] = bf_lo(v.z); x[8 * j + 5] = bf_hi(v.z); x[8 * j + 6] = bf_lo(v.w); x[8 * j + 7] = bf_hi(v.w); }
            float ss = 0.f;
#pragma unroll
            for (int j = 0; j < 16; ++j) ss += x[j] * x[j];
            ss += __shfl_xor(ss, 1); ss += __shfl_xor(ss, 2);
            const float rstd = 1.f / sqrtf(ss * (1.f / 64.f) + EPS);
#pragma unroll
            for (int j = 0; j < 16; ++j) x[j] = x[j] * rstd * qng[16 * qq + j];
            if (qq == 0) {
#pragma unroll
                for (int j = 0; j < 8; ++j) { const float2 cs = ROPE[pos * 8 + j]; const float a = x[j], c = x[8 + j]; x[j] = a * cs.x - c * cs.y; x[8 + j] = c * cs.x + a * cs.y; } }
#pragma unroll
            for (int j = 0; j < 2; ++j) { u32x4 o; o.x = pk2(0.125f * x[8 * j], 0.125f * x[8 * j + 1]); o.y = pk2(0.125f * x[8 * j + 2], 0.125f * x[8 * j + 3]); o.z = pk2(0.125f * x[8 * j + 4], 0.125f * x[8 * j + 5]); o.w = pk2(0.125f * x[8 * j + 6], 0.125f * x[8 * j + 7]);
                *(LAS u32x4*)(L + SW_QS + row * 144 + (16 * qq + 8 * j) * 2) = o; }
        }
        __syncthreads();
        const int kt0 = w < 6 ? w : 6;
        const int qi = 16 * w + l16;
        bf16x8 qf[2];
#pragma unroll
        for (int ks = 0; ks < 2; ++ks) qf[ks] = *(const LAS bf16x8*)(L + SW_QS + qi * 144 + (32 * ks + 8 * g4) * 2);
        const float sink = sinks[h];
        float sc[10][4]; float mx = sink;
#pragma unroll
        for (int t = 0; t < 10; ++t) { const int kt = kt0 + t; f32x4 a4 = {0.f, 0.f, 0.f, 0.f};
#pragma unroll
            for (int ks = 0; ks < 2; ++ks) { const bf16x8 A = *(const LAS bf16x8*)(L + SW_KS + (16 * kt + l16) * 144 + (32 * ks + 8 * g4) * 2);
                a4 = __builtin_amdgcn_mfma_f32_16x16x32_bf16(A, qf[ks], a4, 0, 0, 0); }
#pragma unroll
            for (int i = 0; i < 4; ++i) { const int kp = 16 * kt + 4 * g4 + i; const bool valid = (kp > qi) && (kp <= qi + 128) && (qb > 0 || kp >= 128);
                sc[t][i] = valid ? a4[i] : -1e30f; mx = fmaxf(mx, sc[t][i]); } }
        mx = fmaxf(mx, __shfl_xor(mx, 16)); mx = fmaxf(mx, __shfl_xor(mx, 32));
        float sum = 0.f;
#pragma unroll
        for (int t = 0; t < 10; ++t)
#pragma unroll
            for (int i = 0; i < 4; ++i) { const float p = (sc[t][i] > -1e29f) ? __expf(sc[t][i] - mx) : 0.f; sc[t][i] = p; sum += p; }
        sum += __shfl_xor(sum, 16); sum += __shfl_xor(sum, 32);
        const float inv = 1.f / (sum + __expf(sink - mx));
        f32x4 o4[4];
#pragma unroll
        for (int dt = 0; dt < 4; ++dt) o4[dt] = (f32x4){0.f, 0.f, 0.f, 0.f};
#pragma unroll
        for (int pp = 0; pp < 5; ++pp) { const int ta = 2 * pp, tb = 2 * pp + 1;
            u32x4 pa; pa.x = pk2(sc[ta][0] * inv, sc[ta][1] * inv); pa.y = pk2(sc[ta][2] * inv, sc[ta][3] * inv); pa.z = pk2(sc[tb][0] * inv, sc[tb][1] * inv); pa.w = pk2(sc[tb][2] * inv, sc[tb][3] * inv);
            const bf16x8 A = __builtin_bit_cast(bf16x8, pa);
#pragma unroll
            for (int dt = 0; dt < 4; ++dt) { const int d = 16 * dt + l16;
                const u64 lo = *(const LAS u64*)(L + SW_VT + d * 528 + (16 * (kt0 + ta) + 4 * g4) * 2), hi = *(const LAS u64*)(L + SW_VT + d * 528 + (16 * (kt0 + tb) + 4 * g4) * 2);
                o4[dt] = __builtin_amdgcn_mfma_f32_16x16x32_bf16(A, mk8(lo, hi), o4[dt], 0, 0, 0); } }
#pragma unroll
        for (int dt = 0; dt < 4; ++dt)
#pragma unroll
            for (int i = 0; i < 4; ++i) OB[((size_t)b * SEQ + qb * 128 + 16 * w + 4 * g4 + i) * 1024 + h * 64 + 16 * dt + l16] = (bf16)f2bf(o4[dt][i]);
    }
}
constexpr int PK_SK = 0, PK_S12 = 2 * 128 * 272;
static_assert(PK_S12 + 32 * 512 * 4 <= MISC_OFF, "peer lds");
template <class K> __device__ __forceinline__ K kmax_(K a, K b);
template <class K> __device__ __forceinline__ K kmin_(K a, K b);
template <> __device__ __forceinline__ float kmax_<float>(float a, float b) { return fmaxf(a, b); }
template <> __device__ __forceinline__ float kmin_<float>(float a, float b) { return fminf(a, b); }
struct K2 { unsigned h, l; };
template <> __device__ __forceinline__ K2 kmax_<K2>(K2 a, K2 b) { const bool gt = a.h > b.h; K2 r; r.h = gt ? a.h : b.h; r.l = gt ? a.l : b.l; return r; }
template <> __device__ __forceinline__ K2 kmin_<K2>(K2 a, K2 b) { const bool gt = a.h > b.h; K2 r; r.h = gt ? b.h : a.h; r.l = gt ? b.l : a.l; return r; }
template <class K> __device__ __forceinline__ void ce_(K& a, K& b, bool desc) { const K hi = kmax_<K>(a, b), lo = kmin_<K>(a, b); a = desc ? hi : lo; b = desc ? lo : hi; }
template <class K> __device__ __forceinline__ void sort16_desc(K* v) {
#pragma unroll
    for (int k = 2; k <= 16; k <<= 1)
#pragma unroll
        for (int j = k >> 1; j > 0; j >>= 1)
#pragma unroll
            for (int i = 0; i < 16; ++i) { const int l = i ^ j; if (l > i) ce_<K>(v[i], v[l], (i & k) == 0); }
}
template <class K> __device__ __forceinline__ void bmerge16_desc(K* v) {
#pragma unroll
    for (int j = 8; j > 0; j >>= 1)
#pragma unroll
        for (int i = 0; i < 16; ++i) { const int l = i ^ j; if (l > i) ce_<K>(v[i], v[l], true); }
}
template <class K> __device__ __forceinline__ void merge_top16(K* a, const K* b) {
#pragma unroll
    for (int i = 0; i < 16; ++i) a[i] = kmax_<K>(a[i], b[15 - i]);
    bmerge16_desc<K>(a);
}
template <class K> __device__ __forceinline__ void top16_of_64(K* v) {
    sort16_desc<K>(v); sort16_desc<K>(v + 16); sort16_desc<K>(v + 32); sort16_desc<K>(v + 48);
    merge_top16<K>(v, v + 16); merge_top16<K>(v + 32, v + 48); merge_top16<K>(v, v + 32);
}
__device__ __forceinline__ unsigned ford(float f) { const unsigned u = __builtin_bit_cast(unsigned, f); return (u & 0x80000000u) ? ~u : (u | 0x80000000u); }
__device__ __forceinline__ float funord(unsigned k) { const unsigned u = (k & 0x80000000u) ? (k & 0x7fffffffu) : ~k; return __builtin_bit_cast(float, u); }

__device__ const unsigned char STAIR[64] = {0, 1, 2, 3, 4, 5, 6, 7, 8, 9, 10, 11, 12, 13, 14, 15, 16, 17, 18, 19, 20, 21, 22, 23, 32, 33, 34, 35, 36, 48, 49, 50, 51, 64, 65, 66, 80, 81, 96, 97, 112, 113, 128, 144, 160, 176, 192, 208, 224, 240, 0, 0, 0, 0, 0, 0, 0, 0, 0, 0, 0, 0, 0, 0};
__device__ __forceinline__ void peer_topk_unit(Frame& F, int tile, int hh) {
    using pg8::bf16x8; using pg8::u32x4;
    const ldsp L = F.lds; const int tid = F.tid, lane = F.lane, w = F.wave, hb = lane >> 5, l32 = lane & 31;
    const bf16* QP = (const bf16*)(F.ws + WS_QP); const bf16* SUBK = (const bf16*)(F.ws + WS_SUBK);
    int* IDX = (int*)(F.ws + WS_IDX); float* GATE = (float*)(F.ws + WS_GATE);
    __syncthreads();
    {
        const u32x4* src = (const u32x4*)(SUBK + (size_t)hh * 2 * 128 * 128);
#pragma unroll
        for (int r = 0; r < 8; ++r) { const int idx = tid + r * NTHR; const int row = idx >> 4, c = idx & 15;
            *(LAS u32x4*)(L + PK_SK + row * 272 + c * 16) = src[idx]; }
    }
    __syncthreads();
    const int tok = tile * 256 + 32 * w + l32;
    LAS float* S12 = (LAS float*)(L + PK_S12) + tid;
#pragma unroll 1
    for (int p = 0; p < 2; ++p) {
        bf16x8 Bq[8];
        const u32x4* qsrc = (const u32x4*)(QP + (size_t)tok * 2048 + (2 * hh + p) * 128);
#pragma unroll
        for (int ks = 0; ks < 8; ++ks) Bq[ks] = __builtin_bit_cast(bf16x8, qsrc[2 * ks + hb]);
        float v[16];
#pragma unroll
        for (int kt = 0; kt < 4; ++kt) { f32x16 acc;
#pragma unroll
            for (int i = 0; i < 16; ++i) acc[i] = 0.f;
#pragma unroll
            for (int ks = 0; ks < 8; ++ks) { const bf16x8 A = *(const LAS bf16x8*)(L + PK_SK + (p * 128 + 32 * kt + l32) * 272 + (16 * ks + 8 * hb) * 2);
                acc = __builtin_amdgcn_mfma_f32_32x32x16_bf16(A, Bq[ks], acc, 0, 0, 0); }
            float cur[16];
#pragma unroll
            for (int i = 0; i < 16; ++i) { const int key = 32 * kt + 8 * (i >> 2) + 4 * hb + (i & 3);
                const float sci = acc[i];
                cur[i] = __builtin_bit_cast(float, (__builtin_bit_cast(unsigned, sci) & ~127u) | (unsigned)(127 - key)); }
            sort16_desc<float>(cur);
            if (kt == 0) {
#pragma unroll
                for (int i = 0; i < 16; ++i) v[i] = cur[i]; }
            else merge_top16<float>(v, cur);
            __builtin_amdgcn_sched_barrier(0); }
        float o[16];
#pragma unroll
        for (int i = 0; i < 16; ++i) o[i] = __shfl_xor(v[15 - i], 32);
#pragma unroll
        for (int i = 0; i < 16; ++i) v[i] = fmaxf(v[i], o[i]);
        bmerge16_desc<float>(v);
#pragma unroll
        for (int i = 0; i < 16; ++i) S12[(p * 16 + i) * NTHR] = v[i];
    }
    float s12[2][16];
#pragma unroll
    for (int p = 0; p < 2; ++p)
#pragma unroll
        for (int i = 0; i < 16; ++i) s12[p][i] = S12[(p * 16 + i) * NTHR];
    float c[16];
#pragma unroll
    for (int gq = 0; gq < 4; ++gq) {
        float cur[16];
#pragma unroll
        for (int q = 0; q < 16; ++q) cur[q] = -3.0e38f;
        int n = 0;
#pragma unroll
        for (int i = 0; i < 16; ++i)
#pragma unroll
            for (int j = 0; j < 16; ++j) if ((i + 1) * (j + 1) <= 16) {
                if ((n >> 4) == gq) {
                    const unsigned b1 = __builtin_bit_cast(unsigned, s12[0][i]), b2 = __builtin_bit_cast(unsigned, s12[1][j]);
                    const float sum = __builtin_bit_cast(float, b1 & ~127u) + __builtin_bit_cast(float, b2 & ~127u);
                    cur[n & 15] = __builtin_bit_cast(float, (__builtin_bit_cast(unsigned, sum) & ~63u) | (unsigned)n); }
                ++n; }
        sort16_desc<float>(cur);
        if (gq == 0) {
#pragma unroll
            for (int q = 0; q < 16; ++q) c[q] = cur[q]; }
        else merge_top16<float>(c, cur);
        __builtin_amdgcn_sched_barrier(0);
    }
    float best[16]; int eidx[16]; float m = -3.0e38f;
#pragma unroll
    for (int k = 0; k < 16; ++k) { const unsigned cid = __builtin_bit_cast(unsigned, c[k]) & 63u; const unsigned ij = STAIR[cid];
        const unsigned b1 = __builtin_bit_cast(unsigned, S12[(ij >> 4) * NTHR]), b2 = __builtin_bit_cast(unsigned, S12[(16 + (ij & 15u)) * NTHR]);
        best[k] = __builtin_bit_cast(float, b1 & ~127u) + __builtin_bit_cast(float, b2 & ~127u); m = fmaxf(m, best[k]);
        eidx[k] = (int)(((127u - (b1 & 127u)) << 7) | (127u - (b2 & 127u))); }
    float sum = 0.f;
#pragma unroll
    for (int k = 0; k < 16; ++k) { best[k] = __expf(best[k] - m); sum += best[k]; }
    const float inv = 1.f / sum;
    if (hb == 0) { int4* dst = (int4*)(IDX + (size_t)tok * 128 + hh * 16);
#pragma unroll
        for (int k4 = 0; k4 < 4; ++k4) dst[k4] = make_int4(eidx[4 * k4], eidx[4 * k4 + 1], eidx[4 * k4 + 2], eidx[4 * k4 + 3]); }
    else { float4* dst = (float4*)(GATE + (size_t)tok * 128 + hh * 16);
#pragma unroll
        for (int k4 = 0; k4 < 4; ++k4) dst[k4] = make_float4(best[4 * k4] * inv, best[4 * k4 + 1] * inv, best[4 * k4 + 2] * inv, best[4 * k4 + 3] * inv); }
}


__device__ __forceinline__ void wave_argmax(float& v, int& p) {
#pragma unroll
    for (int o = 1; o < 64; o <<= 1) { const float ov = __shfl_xor(v, o); const int op = __shfl_xor(p, o); const bool t = (ov > v) || (ov == v && op < p); v = t ? ov : v; p = t ? op : p; }
}
__device__ __forceinline__ void peer_topk_slow(Frame& F, int tok, int hh) {
    using pg8::u32x4;
    const int lane = F.lane;
    const bf16* QP = (const bf16*)(F.ws + WS_QP) + (size_t)tok * 2048 + hh * 256; const bf16* SUBK = (const bf16*)(F.ws + WS_SUBK) + (size_t)hh * 2 * 128 * 128;
    float sv[2] = {0.f, 0.f}; int sk[2] = {0, 0};
#pragma unroll 1
    for (int p = 0; p < 2; ++p) {
        float sc0 = 0.f, sc1 = 0.f;
        const u32x4* q4 = (const u32x4*)(QP + p * 128); const u32x4* k0 = (const u32x4*)(SUBK + ((size_t)p * 128 + lane) * 128); const u32x4* k1 = (const u32x4*)(SUBK + ((size_t)p * 128 + lane + 64) * 128);
#pragma unroll 4
        for (int c = 0; c < 16; ++c) { const u32x4 q = q4[c], a = k0[c], b = k1[c];
            sc0 += bf_lo(q.x) * bf_lo(a.x) + bf_hi(q.x) * bf_hi(a.x) + bf_lo(q.y) * bf_lo(a.y) + bf_hi(q.y) * bf_hi(a.y) + bf_lo(q.z) * bf_lo(a.z) + bf_hi(q.z) * bf_hi(a.z) + bf_lo(q.w) * bf_lo(a.w) + bf_hi(q.w) * bf_hi(a.w);
            sc1 += bf_lo(q.x) * bf_lo(b.x) + bf_hi(q.x) * bf_hi(b.x) + bf_lo(q.y) * bf_lo(b.y) + bf_hi(q.y) * bf_hi(b.y) + bf_lo(q.z) * bf_lo(b.z) + bf_hi(q.z) * bf_hi(b.z) + bf_lo(q.w) * bf_lo(b.w) + bf_hi(q.w) * bf_hi(b.w); }
        float wv = 0.f; int wk = 0;
#pragma unroll 1
        for (int it = 0; it < 16; ++it) { float v = sc0 >= sc1 ? sc0 : sc1; int key = sc0 >= sc1 ? lane : lane + 64;
            wave_argmax(v, key);
            if (key == lane) sc0 = -3.0e38f; if (key == lane + 64) sc1 = -3.0e38f;
            if (lane == it) { wv = v; wk = key; } }
        if (p == 0) { sv[0] = wv; sk[0] = wk; } else { sv[1] = wv; sk[1] = wk; }
    }
    float cv[4]; int cp[4];
#pragma unroll
    for (int r = 0; r < 4; ++r) { const int c = lane + 64 * r, i = c >> 4, j = c & 15; cv[r] = __shfl(sv[0], i) + __shfl(sv[1], j); cp[r] = c; }
    float bv = 0.f; int bp = 0;
#pragma unroll 1
    for (int it = 0; it < 16; ++it) { float v = cv[0]; int c = cp[0];
#pragma unroll
        for (int r = 1; r < 4; ++r) if (cv[r] > v) { v = cv[r]; c = cp[r]; }
        wave_argmax(v, c);
#pragma unroll
        for (int r = 0; r < 4; ++r) if (cp[r] == c) cv[r] = -3.0e38f;
        if (lane == it) { bv = v; bp = c; } }
    const int k1 = __shfl(sk[0], bp >> 4), k2 = __shfl(sk[1], bp & 15);
    float m = bv;
#pragma unroll
    for (int o = 1; o < 16; o <<= 1) m = fmaxf(m, __shfl_xor(m, o));
    const float e = __expf(bv - m); float sum = e;
#pragma unroll
    for (int o = 1; o < 16; o <<= 1) sum += __shfl_xor(sum, o);
    if (lane < 16) { ((int*)(F.ws + WS_IDX))[(size_t)tok * 128 + hh * 16 + lane] = k1 * 128 + k2; ((float*)(F.ws + WS_GATE))[(size_t)tok * 128 + hh * 16 + lane] = e / sum; }
}
__device__ __forceinline__ float gelu_erf(float x) { return 0.5f * x * (1.f + erff(x * 0.70710678118654752f)); }
constexpr size_t WS_SCLU = WS_ROPE + 256 * 1024, WS_SCLV = WS_ROPE + 384 * 1024;
constexpr size_t PEER_SLICE = (size_t)16384 * 128;
constexpr size_t WS_PU = 384 * MiB;
typedef float f32x2_t __attribute__((ext_vector_type(2)));
__device__ __forceinline__ void row_to_fp8(int lane, const float* src, unsigned char* dst, float* inv_scale) {
    using pg8::f32x4; using pg8::u32x4;
    const f32x4* s4 = (const f32x4*)src + 4 * lane;
    f32x4 v[4]; float am = 0.f;
#pragma unroll
    for (int j = 0; j < 4; ++j) { v[j] = s4[j]; am = fmaxf(am, fmaxf(fmaxf(fabsf(v[j].x), fabsf(v[j].y)), fmaxf(fabsf(v[j].z), fabsf(v[j].w)))); }
#pragma unroll
    for (int o = 1; o < 64; o <<= 1) am = fmaxf(am, __shfl_xor(am, o));
    float sc = 1.f;
    if (am > 0.f) { int e; (void)frexpf(448.f / am, &e); sc = ldexpf(1.f, e - 1); }
    int p[4];
#pragma unroll
    for (int j = 0; j < 4; ++j) { p[j] = __builtin_amdgcn_cvt_pk_fp8_f32(v[j].x * sc, v[j].y * sc, 0, false); p[j] = __builtin_amdgcn_cvt_pk_fp8_f32(v[j].z * sc, v[j].w * sc, p[j], true); }
    u32x4 o; o.x = (unsigned)p[0]; o.y = (unsigned)p[1]; o.z = (unsigned)p[2]; o.w = (unsigned)p[3];
    *(u32x4*)(dst + (size_t)(lane >> 3) * PEER_SLICE + 16 * (lane & 7)) = o;
    if (lane == 0) *inv_scale = 1.f / sc;
}
struct PeerPre { int rows[16]; pg8::u32x4 x0, x1; };
__device__ __forceinline__ void peer_u_load(Frame& F, int tok, int vs, PeerPre& p) {
    const int lane = F.lane, rsub = lane >> 3, c = lane & 7;
    const bf16* XN = (const bf16*)(F.ws + WS_XN2) + (size_t)tok * D + vs * 128; const int* IDX = (const int*)(F.ws + WS_IDX) + (size_t)tok * 128;
#pragma unroll
    for (int g = 0; g < 16; ++g) p.rows[g] = IDX[(unsigned)(rsub + 8 * g)];
    p.x0 = *(const pg8::u32x4*)(XN + (unsigned)(16 * c)); p.x1 = *(const pg8::u32x4*)(XN + (unsigned)(16 * c + 8));
}
__device__ __forceinline__ void peer_dot8(const pg8::u32x4* ua, const float* xf, float* part) {
    f32x2_t x2[8];
#pragma unroll
    for (int q = 0; q < 8; ++q) x2[q] = (f32x2_t){xf[2 * q], xf[2 * q + 1]};
#pragma unroll
    for (int g = 0; g < 8; ++g) { const unsigned uw[4] = {ua[g].x, ua[g].y, ua[g].z, ua[g].w}; f32x2_t sa = {0.f, 0.f}, sb = {0.f, 0.f};
#pragma unroll
        for (int q = 0; q < 4; ++q) { const f32x2_t a = __builtin_amdgcn_cvt_pk_f32_fp8((int)uw[q], false), b2 = __builtin_amdgcn_cvt_pk_f32_fp8((int)uw[q], true);
            sa = __builtin_elementwise_fma(a, x2[2 * q], sa); sb = __builtin_elementwise_fma(b2, x2[2 * q + 1], sb); }
        const f32x2_t st = sa + sb; part[g] = st.x + st.y; }
}
__device__ __forceinline__ void peer_u_slice(Frame& F, int vs, int tok0, int tstep) {
    using pg8::u32x4;
    const int lane = F.lane, rsub = lane >> 3, c = lane & 7;
    const unsigned char* U8 = F.ws + WS_U + (size_t)vs * PEER_SLICE; const unsigned co = 16u * (unsigned)c;
    if (tok0 >= T) return;
    PeerPre cur, nxt; peer_u_load(F, tok0, vs, cur); nxt = cur;
    float pprev[16]; int tokp = -1;
#pragma unroll
    for (int k = 0; k < 16; ++k) pprev[k] = 0.f;
    u32x4 bufA[8], bufB[8];
#pragma unroll
    for (int g = 0; g < 8; ++g) bufA[g] = *(const u32x4*)(U8 + ((unsigned)cur.rows[g] * 128u + co));
#pragma unroll 1
    for (int tok = tok0; tok < T; tok += tstep) {
        const int tokn = tok + tstep;
#pragma unroll
        for (int g = 0; g < 8; ++g) bufB[g] = *(const u32x4*)(U8 + ((unsigned)cur.rows[8 + g] * 128u + co));
        if (tokn < T) peer_u_load(F, tokn, vs, nxt);
        const unsigned xw[8] = {cur.x0.x, cur.x0.y, cur.x0.z, cur.x0.w, cur.x1.x, cur.x1.y, cur.x1.z, cur.x1.w};
        float xf[16];
#pragma unroll
        for (int q = 0; q < 8; ++q) { xf[2 * q] = bf_lo(xw[q]); xf[2 * q + 1] = bf_hi(xw[q]); }
        float part[16];
        {
            const bool h2 = (lane & 4) != 0, h1 = (lane & 2) != 0, h0 = (lane & 1) != 0;
            float a8[8], b4[4], c2v[2];
#pragma unroll
            for (int k = 0; k < 8; ++k) { const float keep = h2 ? pprev[k + 8] : pprev[k], send = h2 ? pprev[k] : pprev[k + 8]; a8[k] = keep + __shfl_xor(send, 4); }
#pragma unroll
            for (int k = 0; k < 4; ++k) { const float keep = h1 ? a8[k + 4] : a8[k], send = h1 ? a8[k] : a8[k + 4]; b4[k] = keep + __shfl_xor(send, 2); }
#pragma unroll
            for (int k = 0; k < 2; ++k) { const float keep = h0 ? b4[k + 2] : b4[k], send = h0 ? b4[k] : b4[k + 2]; c2v[k] = keep + __shfl_xor(send, 1); }
            const int g0 = 8 * (h2 ? 1 : 0) + 4 * (h1 ? 1 : 0) + 2 * (h0 ? 1 : 0);
            if (tokp >= 0) { float* PU = (float*)(F.ws + WS_PU) + ((size_t)tokp * 8 + vs) * 128; PU[8 * g0 + rsub] = c2v[0]; PU[8 * (g0 + 1) + rsub] = c2v[1]; }
        }
        peer_dot8(bufA, xf, part);
        __builtin_amdgcn_sched_barrier(0);
        if (tokn < T) {
#pragma unroll
            for (int g = 0; g < 8; ++g) bufA[g] = *(const u32x4*)(U8 + ((unsigned)nxt.rows[g] * 128u + co)); }
        peer_dot8(bufB, xf, part + 8);
        __builtin_amdgcn_sched_barrier(0);
#pragma unroll
        for (int k = 0; k < 16; ++k) pprev[k] = part[k];
        tokp = tok;
        cur = nxt;
    }
    {
        const bool h2 = (lane & 4) != 0, h1 = (lane & 2) != 0, h0 = (lane & 1) != 0;
        float a8[8], b4[4], c2v[2];
#pragma unroll
        for (int k = 0; k < 8; ++k) { const float keep = h2 ? pprev[k + 8] : pprev[k], send = h2 ? pprev[k] : pprev[k + 8]; a8[k] = keep + __shfl_xor(send, 4); }
#pragma unroll
        for (int k = 0; k < 4; ++k) { const float keep = h1 ? a8[k + 4] : a8[k], send = h1 ? a8[k] : a8[k + 4]; b4[k] = keep + __shfl_xor(send, 2); }
#pragma unroll
        for (int k = 0; k < 2; ++k) { const float keep = h0 ? b4[k + 2] : b4[k], send = h0 ? b4[k] : b4[k + 2]; c2v[k] = keep + __shfl_xor(send, 1); }
        const int g0 = 8 * (h2 ? 1 : 0) + 4 * (h1 ? 1 : 0) + 2 * (h0 ? 1 : 0);
        if (tokp >= 0) { float* PU = (float*)(F.ws + WS_PU) + ((size_t)tokp * 8 + vs) * 128; PU[8 * g0 + rsub] = c2v[0]; PU[8 * (g0 + 1) + rsub] = c2v[1]; }
    }
}
__device__ __forceinline__ void peer_w_token2(Frame& F, int tokA, int tokB) {
    const int lane = F.lane;
    const float* SCLU = (const float*)(F.ws + WS_SCLU); const float* SCLV = (const float*)(F.ws + WS_SCLV);
    float pu[2][2][8]; int row[2][2]; float gt[2][2];
#pragma unroll
    for (int t = 0; t < 2; ++t) { const int tok = t ? tokB : tokA;
        const float* PU = (const float*)(F.ws + WS_PU) + (size_t)tok * 8 * 128; const int* IDX = (const int*)(F.ws + WS_IDX) + (size_t)tok * 128; const float* GATE = (const float*)(F.ws + WS_GATE) + (size_t)tok * 128;
#pragma unroll
        for (int q = 0; q < 2; ++q) { const int e = lane + 64 * q;
#pragma unroll
            for (int v = 0; v < 8; ++v) pu[t][q][v] = PU[v * 128 + e];
            row[t][q] = IDX[e]; gt[t][q] = GATE[e]; } }
#pragma unroll
    for (int t = 0; t < 2; ++t) { const int tok = t ? tokB : tokA; if (t == 1 && tokB == tokA) break;
        unsigned* REC = (unsigned*)(F.ws + WS_GATE) + (size_t)tok * 128;
#pragma unroll
        for (int q = 0; q < 2; ++q) { const int e = lane + 64 * q; float sacc = 0.f;
#pragma unroll
            for (int v = 0; v < 8; ++v) sacc += pu[t][q][v];
            const float wv_ = gelu_erf(sacc * SCLU[row[t][q]]) * gt[t][q] * SCLV[row[t][q]];
            REC[e] = ((unsigned)row[t][q] << 16) | f2bf(wv_); } }
}
struct PeerPreV { unsigned rec[16]; };
__device__ __forceinline__ void peer_v_load(Frame& F, int tok, PeerPreV& p) {
    const int rsub = F.lane >> 3;
    const unsigned* REC = (const unsigned*)(F.ws + WS_GATE) + (size_t)tok * 128;
#pragma unroll
    for (int g = 0; g < 16; ++g) p.rec[g] = REC[(unsigned)(rsub + 8 * g)];
}
__device__ __forceinline__ void peer_axpy8(const pg8::u32x4* va, const unsigned* rec, f32x2_t* acc2) {
#pragma unroll
    for (int g = 0; g < 8; ++g) { const unsigned vw[4] = {va[g].x, va[g].y, va[g].z, va[g].w}; const float wg_ = __builtin_bit_cast(float, rec[g] << 16); const f32x2_t w2 = {wg_, wg_};
#pragma unroll
        for (int q = 0; q < 4; ++q) { const f32x2_t a = __builtin_amdgcn_cvt_pk_f32_fp8((int)vw[q], false), b2 = __builtin_amdgcn_cvt_pk_f32_fp8((int)vw[q], true);
            acc2[2 * q] = __builtin_elementwise_fma(w2, a, acc2[2 * q]); acc2[2 * q + 1] = __builtin_elementwise_fma(w2, b2, acc2[2 * q + 1]); } }
}
__device__ __forceinline__ void peer_v_slice(Frame& F, int vs, int tok0, int tstep) {
    using pg8::u32x4;
    const int lane = F.lane, c = lane & 7;
    const unsigned char* V8 = F.ws + WS_V + (size_t)vs * PEER_SLICE; const unsigned co = 16u * (unsigned)c;
    if (tok0 >= T) return;
    PeerPreV cur, nxt; peer_v_load(F, tok0, cur); nxt = cur;
    float aprev[16]; int tokp = -1;
#pragma unroll
    for (int k = 0; k < 16; ++k) aprev[k] = 0.f;
    u32x4 bufA[8], bufB[8];
#pragma unroll
    for (int g = 0; g < 8; ++g) bufA[g] = *(const u32x4*)(V8 + ((cur.rec[g] >> 16) * 128u + co));
#pragma unroll 1
    for (int tok = tok0; tok < T; tok += tstep) {
        const int tokn = tok + tstep;
#pragma unroll
        for (int g = 0; g < 8; ++g) bufB[g] = *(const u32x4*)(V8 + ((cur.rec[8 + g] >> 16) * 128u + co));
        if (tokn < T) peer_v_load(F, tokn, nxt);
        f32x2_t acc2[8];
#pragma unroll
        for (int j = 0; j < 8; ++j) acc2[j] = (f32x2_t){0.f, 0.f};
        {
            const bool h5 = (lane & 32) != 0, h4 = (lane & 16) != 0, h3 = (lane & 8) != 0;
            float a8[8], b4[4], c2v[2];
#pragma unroll
            for (int k = 0; k < 8; ++k) { const float keep = h5 ? aprev[k + 8] : aprev[k], send = h5 ? aprev[k] : aprev[k + 8]; a8[k] = keep + __shfl_xor(send, 32); }
#pragma unroll
            for (int k = 0; k < 4; ++k) { const float keep = h4 ? a8[k + 4] : a8[k], send = h4 ? a8[k] : a8[k + 4]; b4[k] = keep + __shfl_xor(send, 16); }
#pragma unroll
            for (int k = 0; k < 2; ++k) { const float keep = h3 ? b4[k + 2] : b4[k], send = h3 ? b4[k] : b4[k + 2]; c2v[k] = keep + __shfl_xor(send, 8); }
            const int j0 = 8 * (h5 ? 1 : 0) + 4 * (h4 ? 1 : 0) + 2 * (h3 ? 1 : 0);
            if (tokp >= 0) { float2* op = (float2*)(F.out + (size_t)tokp * D + vs * 128 + 16 * c + j0); float2 r = *op; r.x += c2v[0]; r.y += c2v[1]; *op = r; }
        }
        peer_axpy8(bufA, cur.rec, acc2);
        __builtin_amdgcn_sched_barrier(0);
        if (tokn < T) {
#pragma unroll
            for (int g = 0; g < 8; ++g) bufA[g] = *(const u32x4*)(V8 + ((nxt.rec[g] >> 16) * 128u + co)); }
        peer_axpy8(bufB, cur.rec + 8, acc2);
        __builtin_amdgcn_sched_barrier(0);
#pragma unroll
        for (int j = 0; j < 8; ++j) { aprev[2 * j] = acc2[j].x; aprev[2 * j + 1] = acc2[j].y; }
        tokp = tok;
        cur = nxt;
    }
    {
            const bool h5 = (lane & 32) != 0, h4 = (lane & 16) != 0, h3 = (lane & 8) != 0;
            float a8[8], b4[4], c2v[2];
#pragma unroll
            for (int k = 0; k < 8; ++k) { const float keep = h5 ? aprev[k + 8] : aprev[k], send = h5 ? aprev[k] : aprev[k + 8]; a8[k] = keep + __shfl_xor(send, 32); }
#pragma unroll
            for (int k = 0; k < 4; ++k) { const float keep = h4 ? a8[k + 4] : a8[k], send = h4 ? a8[k] : a8[k + 4]; b4[k] = keep + __shfl_xor(send, 16); }
#pragma unroll
            for (int k = 0; k < 2; ++k) { const float keep = h3 ? b4[k + 2] : b4[k], send = h3 ? b4[k] : b4[k + 2]; c2v[k] = keep + __shfl_xor(send, 8); }
            const int j0 = 8 * (h5 ? 1 : 0) + 4 * (h4 ? 1 : 0) + 2 * (h3 ? 1 : 0);
            if (tokp >= 0) { float2* op = (float2*)(F.out + (size_t)tokp * D + vs * 128 + 16 * c + j0); float2 r = *op; r.x += c2v[0]; r.y += c2v[1]; *op = r; }
    }
}

struct Args { const float* in[17]; float* out; unsigned char* ws; int ph_lo, ph_hi; };
constexpr int N_PHASES = 13;
__global__ void __launch_bounds__(NTHR, 2) mega_fwd(Args args) {
    extern __shared__ __attribute__((aligned(16))) unsigned char lds[];
    Frame F;
    F.lds = (ldsp)lds; F.ws = args.ws; F.out = args.out;
#pragma unroll
    for (int i = 0; i < 17; ++i) F.in[i] = args.in[i];
    F.tid = threadIdx.x; F.lane = F.tid & 63; F.wave = __builtin_amdgcn_readfirstlane(F.tid >> 6);
    F.G = gridDim.x; { const int bx = blockIdx.x; F.vcu = (F.G % 8 == 0) ? (bx % 8) * (F.G / 8) + bx / 8 : bx; }
    volatile LAS unsigned* MISC = (volatile LAS unsigned*)(F.lds + MISC_OFF);
    if (F.tid < 64) MISC[F.tid] = 0u;
    __syncthreads();
    XcdBarrier bar = xcd_barrier_post((unsigned*)(args.ws + WS_CTL) + CW_BAR, MISC + 8);
    const int lo = args.ph_lo, hi = args.ph_hi;
#define IN(k) (lo <= (k) && (k) < hi)
#define SEAM(k) do { if (IN(k) && IN((k) + 1)) xcd_barrier(bar); } while (0)

    if (IN(0)) { p0_prologue(F); } SEAM(0);
    if (IN(1)) {
        pg8::Gemm g{(const pg8::bf16_t*)(F.ws + WS_H), (const pg8::bf16_t*)(F.ws + WS_WIN), T, NPROJ, D}; pg8::StaticOrder S; S.init(T, NPROJ, F.G, (int)blockIdx.x);
        EpiB<0> E{F.ws}; pg8::gemm_phase<EpiB<0>, pg8::StaticOrder, true, true>(F.lds, g, S, E);
    } SEAM(1);
    if (IN(2)) {
        PreRegs cur, nxt; cur.gl = (pg8::f32x4){0.f, 0.f, 0.f, 0.f};
        if (F.vcu < 2048) gla_pre_load(F, F.vcu, cur);
        nxt = cur;
        for (int u = F.vcu; u < 2048; u += F.G) { if (u + F.G < 2048) gla_pre_load(F, u + F.G, nxt); gla_pre_unit(F, u >> 7, (u >> 5) & 3, u & 31, cur); cur = nxt; }
    } SEAM(2);
    if (IN(3)) {
        const int nG = (F.G >= 128) ? 64 : (F.G / 2 > 0 ? F.G / 2 : 1);
        if (F.G == 1) { for (int u = 0; u < 64; ++u) gla_unit(F, u >> 2, u & 3); }
        if (F.G > 1 && F.vcu < nG) { for (int u = F.vcu; u < 64; u += nG) gla_unit(F, u >> 2, u & 3); }
        else { const int nS = F.G > 1 ? F.G - nG : 1, v0 = F.G > 1 ? F.vcu - nG : 0; for (int u = v0; u < 1024; u += nS) swa_unit(F, u >> 6, (u >> 2) & 15, u & 3);
            for (int r = v0 * NWAVES + F.wave; r < 2 * 16384; r += nS * NWAVES) { const int tb = r >= 16384, row = r & 16383;
                row_to_fp8(F.lane, F.in[tb ? 16 : 15] + (size_t)row * D, F.ws + (tb ? WS_V : WS_U) + (size_t)row * 128, (float*)(F.ws + (tb ? WS_SCLV : WS_SCLU)) + row); } }
    } SEAM(3);
    if (IN(4)) {
        for (int u = F.vcu; u < 2048; u += F.G) gla_post_unit(F, u >> 7, (u >> 5) & 3, u & 31);
    } SEAM(4);
    if (IN(5)) {
        { pg8::Gemm g{(const pg8::bf16_t*)F.out, (const pg8::bf16_t*)(F.ws + WS_WA), T, D, D}; pg8::StaticOrder S; S.init(T, D, F.G, (int)blockIdx.x);
          EpiB<1> E{F.ws}; pg8::gemm_phase<EpiB<1>, pg8::StaticOrder, true, true>(F.lds, g, S, E); }
        asm volatile("s_waitcnt vmcnt(0)" ::: "memory"); __syncthreads();
        { pg8::Gemm g{(const pg8::bf16_t*)F.out + (size_t)T * D, (const pg8::bf16_t*)(F.ws + WS_WB), T, D, D}; pg8::StaticOrder S; S.init(T, D, F.G, (int)blockIdx.x);
          EpiB<2> E{F.ws}; pg8::gemm_phase<EpiB<2>, pg8::StaticOrder, true, true>(F.lds, g, S, E); }
    } SEAM(5);
    if (IN(6)) {
        pg8::Gemm g{(const pg8::bf16_t*)(F.ws + WS_YA), (const pg8::bf16_t*)(F.ws + WS_WO), T, D, D}; pg8::StaticOrder S; S.init(T, D, F.G, (int)blockIdx.x);
        EpiX1 E{F.in[0], F.out}; pg8::gemm_phase<EpiX1, pg8::StaticOrder, true, true>(F.lds, g, S, E);
    } SEAM(6);
    if (IN(7)) {
        const int gw = F.vcu * NWAVES + F.wave, NGW = F.G * NWAVES;
        for (int m = gw; m < T; m += 2 * NGW) { const int m2 = m + NGW;
            const f32x4* xa = (const f32x4*)(F.out + (size_t)m * D) + F.lane; const f32x4* xb = (const f32x4*)(F.out + (size_t)(m2 < T ? m2 : m) * D) + F.lane; const f32x4* gr = (const f32x4*)F.in[12] + F.lane;
            f32x4 va[4], vb[4]; float sa = 0.f, sb = 0.f;
#pragma unroll
            for (int j = 0; j < 4; ++j) { va[j] = xa[64 * j]; vb[j] = xb[64 * j]; }
#pragma unroll
            for (int j = 0; j < 4; ++j) { sa += (va[j].x * va[j].x + va[j].y * va[j].y) + (va[j].z * va[j].z + va[j].w * va[j].w); sb += (vb[j].x * vb[j].x + vb[j].y * vb[j].y) + (vb[j].z * vb[j].z + vb[j].w * vb[j].w); }
            sa = wave_sum(sa); sb = wave_sum(sb);
            const float ra = 1.f / sqrtf(sa * (1.f / D) + EPS), rb = 1.f / sqrtf(sb * (1.f / D) + EPS);
            u64* oa = (u64*)((bf16*)(F.ws + WS_XN2) + (size_t)m * D) + F.lane; u64* ob = (u64*)((bf16*)(F.ws + WS_XN2) + (size_t)(m2 < T ? m2 : m) * D) + F.lane;
#pragma unroll
            for (int j = 0; j < 4; ++j) { const f32x4 gg = gr[64 * j];
                oa[64 * j] = (u64)pk2(va[j].x * ra * gg.x, va[j].y * ra * gg.y) | ((u64)pk2(va[j].z * ra * gg.z, va[j].w * ra * gg.w) << 32);
                if (m2 < T) ob[64 * j] = (u64)pk2(vb[j].x * rb * gg.x, vb[j].y * rb * gg.y) | ((u64)pk2(vb[j].z * rb * gg.z, vb[j].w * rb * gg.w) << 32); } }
    } SEAM(7);
    if (IN(8)) {
        pg8::Gemm g{(const pg8::bf16_t*)(F.ws + WS_XN2), (const pg8::bf16_t*)(F.ws + WS_WPQ), T, 2048, D}; pg8::StaticOrder S; S.init(T, 2048, F.G, (int)blockIdx.x);
        EpiB<3> E{F.ws}; pg8::gemm_phase<EpiB<3>, pg8::StaticOrder, true, true>(F.lds, g, S, E);
    } SEAM(8);
    if (IN(9)) { for (int u = F.vcu; u < 128 * 8; u += F.G) peer_topk_unit(F, u >> 3, u & 7); } SEAM(9);
    const bool sl8 = (F.G % 8) == 0; const int my_vs = (int)blockIdx.x & 7, my_w = ((int)blockIdx.x >> 3) * NWAVES + F.wave, n_w = (F.G >> 3) * NWAVES;
    if (IN(10)) {
        if (sl8) peer_u_slice(F, my_vs, my_w, n_w);
        else { for (int vs = 0; vs < 8; ++vs) peer_u_slice(F, vs, F.vcu * NWAVES + F.wave, F.G * NWAVES); }
    } SEAM(10);
    if (IN(11)) { const int gw = F.vcu * NWAVES + F.wave, NGW = F.G * NWAVES; for (int tok = gw; tok < T; tok += 2 * NGW) peer_w_token2(F, tok, tok + NGW < T ? tok + NGW : tok); } SEAM(11);
    if (IN(12)) {
        if (sl8) peer_v_slice(F, my_vs, my_w, n_w);
        else { for (int vs = 0; vs < 8; ++vs) peer_v_slice(F, vs, F.vcu * NWAVES + F.wave, F.G * NWAVES); }
    }
#undef IN
#undef SEAM
}

extern "C" void kernel_launch(void* const* d_in, const int* in_sizes, int n_in, void* d_out, int out_size, void* d_ws, size_t ws_size, hipStream_t stream) {
    static int grid = 0;
    if (grid == 0) {
        if (n_in != 17 || out_size != T * D || ws_size < WS_END) { fprintf(stderr, "kernel_launch: unexpected shapes (n_in %d out %d ws %zu)\n", n_in, out_size, ws_size); grid = -1; return; }
        int dev = 0, cus = 0, per_cu = 0;
        if (hipGetDevice(&dev) != hipSuccess || hipDeviceGetAttribute(&cus, hipDeviceAttributeMultiprocessorCount, dev) != hipSuccess) { grid = -1; return; }
        if (hipFuncSetAttribute((const void*)mega_fwd, hipFuncAttributeMaxDynamicSharedMemorySize, LDS_BYTES) != hipSuccess) { fprintf(stderr, "kernel_launch: hipFuncSetAttribute failed\n"); grid = -1; return; }
        if (hipOccupancyMaxActiveBlocksPerMultiprocessor(&per_cu, (const void*)mega_fwd, NTHR, LDS_BYTES) != hipSuccess || per_cu < 1) { fprintf(stderr, "kernel_launch: occupancy query gave %d\n", per_cu); per_cu = 1; }
        (void)hipGetLastError();
        grid = cus;
    }
    if (grid < 0) return;
    (void)hipMemsetAsync((char*)d_ws + WS_CTL, 0, CTL_ZERO_BYTES, stream);
    Args a{};
    for (int i = 0; i < 17; ++i) a.in[i] = (const float*)d_in[i];
    a.out = (float*)d_out; a.ws = (unsigned char*)d_ws;
#ifndef MK_SPLIT
    a.ph_lo = 0; a.ph_hi = N_PHASES;
    void* kargs[] = {&a};
    hipError_t e = hipLaunchCooperativeKernel((const void*)mega_fwd, dim3(grid), dim3(NTHR), kargs, LDS_BYTES, stream);
    if (e != hipSuccess) fprintf(stderr, "kernel_launch: cooperative launch failed: %s\n", hipGetErrorString(e));
#else
    const int seq[] = {PHSEQ};
    for (int p : seq) { a.ph_lo = p; a.ph_hi = p + 1; hipLaunchKernelGGL(mega_fwd, dim3(grid), dim3(NTHR), LDS_BYTES, stream, a); }
#endif
}
```

```cpp
#include <hip/hip_runtime.h>
#include <cstdio>
#include <cstdint>
namespace pg8 {
#define PG8_LAS __attribute__((address_space(3)))
typedef unsigned short bf16_t;
typedef short bf16x8 __attribute__((ext_vector_type(8)));
typedef float f32x4 __attribute__((ext_vector_type(4)));
typedef unsigned u32x4 __attribute__((ext_vector_type(4)));
constexpr int BM = 256, BK = 64, HALF = 128, HTB = HALF * BK * 2  , STAGE_BYTES = 8 * HTB, NXCD = 8, WGM = 8;

__host__ __device__ __forceinline__ int lds_byte(int r, int c) { const int st = (r >> 4) * 2 + (c >> 5), rr = r & 15, cc = c & 31, ob = rr * 64 + cc * 2; return st * 1024 + (ob ^ (((ob >> 9) & 1) << 5)); }
__host__ __device__ __forceinline__ void stage_rc(int b, int& R, int& C) { const int st = b / 1024, sb = b % 1024, swz = sb ^ (((sb >> 9) & 1) << 5); R = (st >> 1) * 16 + swz / 64; C = (st & 1) * 32 + (swz % 64) / 2; }
__host__ __device__ __forceinline__ int perm32(int rho) { const int n = rho >> 4, i = rho & 15; return 8 * (i >> 2) + 4 * n + (i & 3); }

struct Unit { int pm, pn; };
struct Gemm { const bf16_t* A; const bf16_t* Bt; int M, N, K; };

struct StaticOrder {
    int nM, nN, nwg, G, c;
    __host__ __device__ void init(int M, int N, int G_, int c_) { nM = M / BM; nN = N / BM; nwg = nM * nN; G = G_; c = c_; }
    __host__ __device__ bool next(int i, Unit& u) const {
        const long L = (long)i * G + c; if (L >= nwg) return false;
        int wgid = (int)L; { const int q = nwg / NXCD, r = nwg % NXCD, xcd = wgid % NXCD, off = wgid / NXCD; wgid = (xcd < r ? xcd * (q + 1) : r * (q + 1) + (xcd - r) * q) + off; }
        const int nig = WGM * nN, gid = wgid / nig, fm = gid * WGM, gsz = (nM - fm) < WGM ? (nM - fm) : WGM;
        u.pm = fm + ((wgid % nig) % gsz); u.pn = (wgid % nig) / gsz; return true;
    }
    __device__ __forceinline__ void a_ready(const Unit&) const {}
    __device__ __forceinline__ void done(const Unit&) const {}
};
__device__ __forceinline__ unsigned cvt_pk_bf16(float lo, float hi) { unsigned r; asm volatile("v_cvt_pk_bf16_f32 %0, %1, %2" : "=v"(r) : "v"(lo), "v"(hi)); return r; }
typedef float f32x2 __attribute__((ext_vector_type(2)));
template <class Epi, class Sched, bool ALIGN_EPI = false, bool SP2 = false>
__device__ __forceinline__ void gemm_phase(PG8_LAS unsigned char* lds, const Gemm g, const Sched& S, const Epi& E) {
    const int tid = threadIdx.x, wid = __builtin_amdgcn_readfirstlane(tid >> 6), lane = tid & 63, wr = wid >> 2, wc = wid & 3, fr = lane & 15, fq = lane >> 4;
    const int K = g.K, nt = K / BK;
    unsigned voffA[2], voffB[2];
#pragma unroll
    for (int i = 0; i < 2; ++i) { int R, C; stage_rc(tid * 16 + i * 8192, R, C); const int Rb = Epi::PERM ? ((R & ~31) + perm32(R & 31)) : R;
        voffA[i] = (unsigned)(R * K + C) * 2u; voffB[i] = (unsigned)(Rb * K + C) * 2u; }
    const size_t kstep = (size_t)(BK * 2);
    const size_t hstep = (size_t)HALF * K * 2;
    const size_t tstep = 2 * hstep;
    const unsigned ldsw = (unsigned)wid * 1024u;
    const int aoff = lds_byte(wr * 64 + fr, fq * 8), boff = lds_byte(wc * 32 + fr, fq * 8);
#define PG8_SA(b, h) (((b) * 2 + (h)) * HTB)
#define PG8_SB(b, h) ((4 + (b) * 2 + (h)) * HTB)
#define PG8_STAGE(bufoff, gbase, voff) do { _Pragma("unroll") for (int _i = 0; _i < 2; ++_i) \
        __builtin_amdgcn_global_load_lds((const unsigned*)((const char*)(gbase) + (voff)[_i]), (PG8_LAS unsigned*)(lds + (bufoff) + ldsw + _i * 8192), 16, 0, 0); } while (0)
#define PG8_LDA(dst, b, h) do { _Pragma("unroll") for (int m = 0; m < 4; ++m) _Pragma("unroll") for (int k = 0; k < 2; ++k) dst[m][k] = *(const PG8_LAS bf16x8*)(lds + PG8_SA(b, h) + aoff + m * 2048 + k * 1024); } while (0)
#define PG8_LDB(dst, b, h) do { _Pragma("unroll") for (int n = 0; n < 2; ++n) _Pragma("unroll") for (int k = 0; k < 2; ++k) dst[n][k] = *(const PG8_LAS bf16x8*)(lds + PG8_SB(b, h) + boff + n * 2048 + k * 1024); } while (0)
#define PG8_MMA(ai, bj, At, Bt) do { __builtin_amdgcn_s_setprio(1); _Pragma("unroll") for (int m = 0; m < 4; ++m) _Pragma("unroll") for (int n = 0; n < 2; ++n) _Pragma("unroll") for (int k = 0; k < 2; ++k) \
        acc[ai][bj][m][n] = __builtin_amdgcn_mfma_f32_16x16x32_bf16(Bt[n][k], At[m][k], acc[ai][bj][m][n], 0, 0, 0); __builtin_amdgcn_s_setprio(0); } while (0)
#define PG8_WAIT_V(n) asm volatile("s_waitcnt vmcnt(" #n ")" ::: "memory")
#define PG8_WAIT_L(n) asm volatile("s_waitcnt lgkmcnt(" #n ")" ::: "memory")
#define PG8_BAR __builtin_amdgcn_s_barrier()
#define PG8_SCHED __builtin_amdgcn_sched_barrier(0)
    Unit cur, nxt; int ui = 0;
    if (!S.next(0, cur)) return;
    f32x4 acc[2][2][4][2];
#pragma unroll
    for (int a = 0; a < 2; ++a)
#pragma unroll
        for (int b = 0; b < 2; ++b)
#pragma unroll
            for (int m = 0; m < 4; ++m)
#pragma unroll
                for (int n = 0; n < 2; ++n) acc[a][b][m][n] = (f32x4){0.f, 0.f, 0.f, 0.f};
    bf16x8 At[4][2], B0[2][2], B1[2][2];
    const char* cA = (const char*)g.A + (size_t)cur.pm * tstep; const char* cB = (const char*)g.Bt + (size_t)cur.pn * tstep;
    S.a_ready(cur);
    if constexpr (SP2) {
        PG8_STAGE(PG8_SB(0, 0), cB, voffB); PG8_STAGE(PG8_SB(0, 1), cB + hstep, voffB); PG8_STAGE(PG8_SA(0, 0), cA, voffA); PG8_STAGE(PG8_SA(0, 1), cA + hstep, voffA);
        if (wr == 1) PG8_BAR;
        PG8_WAIT_V(2); PG8_BAR;
        PG8_STAGE(PG8_SB(1, 0), cB + kstep, voffB); PG8_STAGE(PG8_SA(1, 0), cA + kstep, voffA); PG8_STAGE(PG8_SB(1, 1), cB + hstep + kstep, voffB);
        PG8_WAIT_V(6); PG8_BAR;
    } else {
        PG8_STAGE(PG8_SB(0, 0), cB, voffB); PG8_STAGE(PG8_SA(0, 0), cA, voffA); PG8_STAGE(PG8_SB(0, 1), cB + hstep, voffB); PG8_STAGE(PG8_SA(0, 1), cA + hstep, voffA);
        if (wr == 1) PG8_BAR;
        PG8_WAIT_V(4); PG8_BAR;
        PG8_STAGE(PG8_SB(1, 0), cB + kstep, voffB); PG8_STAGE(PG8_SA(1, 0), cA + kstep, voffA); PG8_STAGE(PG8_SB(1, 1), cB + hstep + kstep, voffB);
        PG8_WAIT_V(6); PG8_BAR;
    }
    for (;;) {
        const bool has_next = S.next(ui + 1, nxt);
        const char* nA = has_next ? (const char*)g.A + (size_t)nxt.pm * tstep : cA; const char* nB = has_next ? (const char*)g.Bt + (size_t)nxt.pn * tstep : cB;
        for (int t = 0; t < nt; t += 2) {
            const bool last = (t == nt - 2);
            const char* a1 = cA + (size_t)(t + 1) * kstep;
            const char* a2 = last ? nA : cA + (size_t)(t + 2) * kstep; const char* b2 = last ? nB : cB + (size_t)(t + 2) * kstep;
            const char* a3 = a2 + kstep; const char* b3 = b2 + kstep;
            if (last && has_next) S.a_ready(nxt);
            if constexpr (SP2) {
            PG8_LDB(B0, 0, 0); PG8_LDB(B1, 0, 1); PG8_SCHED; PG8_LDA(At, 0, 0); PG8_STAGE(PG8_SA(1, 1), a1 + hstep, voffA);
            PG8_WAIT_V(8); PG8_WAIT_L(0); PG8_BAR; PG8_MMA(0, 0, At, B0); PG8_MMA(0, 1, At, B1); PG8_BAR; PG8_SCHED;
            PG8_LDA(At, 0, 1); PG8_STAGE(PG8_SB(0, 0), b2, voffB); PG8_STAGE(PG8_SB(0, 1), b2 + hstep, voffB); PG8_STAGE(PG8_SA(0, 0), a2, voffA);
            PG8_WAIT_V(8); PG8_WAIT_L(0); PG8_BAR; PG8_MMA(1, 0, At, B0); PG8_MMA(1, 1, At, B1); PG8_BAR; PG8_SCHED;
            PG8_LDB(B0, 1, 0); PG8_LDB(B1, 1, 1); PG8_SCHED; PG8_LDA(At, 1, 0); PG8_STAGE(PG8_SA(0, 1), a2 + hstep, voffA);
            PG8_WAIT_V(8); PG8_WAIT_L(0); PG8_BAR; PG8_MMA(0, 0, At, B0); PG8_MMA(0, 1, At, B1); PG8_BAR; PG8_SCHED;
            PG8_LDA(At, 1, 1); PG8_STAGE(PG8_SB(1, 0), b3, voffB); PG8_STAGE(PG8_SB(1, 1), b3 + hstep, voffB); PG8_STAGE(PG8_SA(1, 0), a3, voffA);
            PG8_WAIT_V(8); PG8_WAIT_L(0); PG8_BAR; PG8_MMA(1, 0, At, B0); PG8_MMA(1, 1, At, B1); PG8_BAR; PG8_SCHED;
            } else {
            PG8_LDB(B0, 0, 0); PG8_SCHED; PG8_LDA(At, 0, 0); PG8_STAGE(PG8_SA(1, 1), a1 + hstep, voffA);
            PG8_WAIT_L(8); PG8_BAR; PG8_WAIT_L(0); PG8_MMA(0, 0, At, B0); PG8_BAR; PG8_SCHED;
            PG8_LDB(B1, 0, 1); PG8_STAGE(PG8_SB(0, 0), b2, voffB);
            PG8_BAR; PG8_WAIT_L(0); PG8_MMA(0, 1, At, B1); PG8_BAR;
            PG8_LDA(At, 0, 1); PG8_STAGE(PG8_SA(0, 0), a2, voffA);
            PG8_BAR; PG8_WAIT_L(0); PG8_MMA(1, 0, At, B0); PG8_BAR; PG8_SCHED;
            PG8_STAGE(PG8_SB(0, 1), b2 + hstep, voffB);
            PG8_WAIT_V(6); PG8_BAR; PG8_MMA(1, 1, At, B1); PG8_BAR;
            PG8_LDB(B0, 1, 0); PG8_SCHED; PG8_LDA(At, 1, 0); PG8_STAGE(PG8_SA(0, 1), a2 + hstep, voffA);
            PG8_WAIT_L(8); PG8_BAR; PG8_WAIT_L(0); PG8_MMA(0, 0, At, B0); PG8_BAR; PG8_SCHED;
            PG8_LDB(B1, 1, 1); PG8_STAGE(PG8_SB(1, 0), b3, voffB);
            PG8_BAR; PG8_WAIT_L(0); PG8_MMA(0, 1, At, B1); PG8_BAR;
            PG8_LDA(At, 1, 1); PG8_STAGE(PG8_SA(1, 0), a3, voffA);
            PG8_BAR; PG8_WAIT_L(0); PG8_MMA(1, 0, At, B0); PG8_BAR; PG8_SCHED;
            PG8_STAGE(PG8_SB(1, 1), b3 + hstep, voffB);
            PG8_WAIT_V(6); PG8_BAR; PG8_MMA(1, 1, At, B1); PG8_BAR;
            }
        }
        if constexpr (ALIGN_EPI) { if (wr == 0) PG8_BAR; }
        if constexpr (!Epi::AFTER_DRAIN) { E(acc, cur, wr, wc, fr, fq); S.done(cur); }
        if (!has_next) break;
#pragma unroll
        for (int a = 0; a < 2; ++a)
#pragma unroll
            for (int b = 0; b < 2; ++b)
#pragma unroll
                for (int m = 0; m < 4; ++m)
#pragma unroll
                    for (int n = 0; n < 2; ++n) acc[a][b][m][n] = (f32x4){0.f, 0.f, 0.f, 0.f};
        cur = nxt; cA = nA; cB = nB; ++ui;
        if constexpr (ALIGN_EPI) { if (wr == 1) PG8_BAR; }
    }
    PG8_WAIT_V(0);
    if constexpr (!ALIGN_EPI) { if (wr == 0) PG8_BAR; }
    PG8_BAR;
    if constexpr (Epi::AFTER_DRAIN) { E.fused(acc, cur, wr, wc, fr, fq, lds, wid, lane); S.done(cur); }
#undef PG8_SA
#undef PG8_SB
#undef PG8_STAGE
#undef PG8_LDA
#undef PG8_LDB
#undef PG8_MMA
#undef PG8_WAIT_V
#undef PG8_WAIT_L
#undef PG8_BAR
#undef PG8_SCHED
}
}
#define GAS __attribute__((address_space(1)))
#define LAS __attribute__((address_space(3)))
typedef unsigned short bf16;
typedef unsigned v4u __attribute__((ext_vector_type(4)));
typedef float f32x4 __attribute__((ext_vector_type(4)));
typedef short bf16x8 __attribute__((ext_vector_type(8)));
typedef GAS unsigned gu32;
typedef GAS unsigned long long gu64;
#define RLX_AGENT __ATOMIC_RELAXED, __HIP_MEMORY_SCOPE_AGENT
#define LDS_WAIT() asm volatile("s_waitcnt lgkmcnt(0)" ::: "memory")
#define VM_WAIT() asm volatile("s_waitcnt vmcnt(0)" ::: "memory")
__device__ __forceinline__ unsigned long long rt() { return __builtin_amdgcn_s_memrealtime(); }
__device__ __forceinline__ unsigned f2bf(float f) { unsigned u = __builtin_bit_cast(unsigned, f); return (u + 0x7fffu + ((u >> 16) & 1u)) >> 16; }
__device__ __forceinline__ unsigned pk2(float lo, float hi) { return f2bf(lo) | (f2bf(hi) << 16); }
#define XB_TMO      128
#define XB_XCNT(j)  (256  + 64 * (j))
#define XB_XSUB(j)  (1280 + 64 * (j))
#define XB_XGEN(j)  (2304 + 64 * (j))
#define XB_TOP      3328
#define XB_TOPGEN   3392
#define XCD_BAR_WORDS 3456
#define XB_SPIN_CAP (1u << 18)

__device__ __forceinline__ unsigned xb_ld(unsigned* p)              { return __hip_atomic_load(p, __ATOMIC_RELAXED, __HIP_MEMORY_SCOPE_AGENT); }
__device__ __forceinline__ unsigned xb_add(unsigned* p, unsigned v) { return __hip_atomic_fetch_add(p, v, __ATOMIC_RELAXED, __HIP_MEMORY_SCOPE_AGENT); }
__device__ __forceinline__ unsigned xb_xcc_id() { return (unsigned)__builtin_amdgcn_s_getreg((3 << 11) | 20) & 0xFu; }
#define XB_SPIN(cond, bar) do { unsigned _sp = 0; while (cond) { __builtin_amdgcn_s_sleep(1); \
    if ((++_sp & 255u) == 0u) { if (xb_ld(&(bar)[XB_TMO])) break; if (_sp > XB_SPIN_CAP) { atomicAdd(&(bar)[XB_TMO], 1u); break; } } } } while (0)

struct XcdBarrier {
    unsigned* bar; unsigned x;
    volatile LAS unsigned* st;
};

__device__ __forceinline__ XcdBarrier xcd_barrier_post(unsigned* bar, volatile LAS unsigned* st) {
    XcdBarrier b; b.bar = bar; b.x = xb_xcc_id(); b.st = st;
    if (threadIdx.x == 0) (void)xb_add(&bar[XB_XCNT(b.x)], 1u);
    return b;
}
__device__ __forceinline__ void xcd_barrier_complete(unsigned* bar, unsigned x, unsigned& nloc, unsigned& nx) {
    const unsigned G = gridDim.x * gridDim.y * gridDim.z;
    unsigned sum, cnt, mine, sp = 0u;
    for (;;) {
        sum = 0u; cnt = 0u; mine = 0u;
#pragma unroll
        for (unsigned j = 0; j < 16; ++j) { const unsigned c = xb_ld(&bar[XB_XCNT(j)]); sum += c; cnt += (c > 0u) ? 1u : 0u; mine = (j == x) ? c : mine; }
        if (sum == G) break;
        __builtin_amdgcn_s_sleep(1);
        if ((++sp & 255u) == 0u) { if (xb_ld(&bar[XB_TMO])) break; if (sp > XB_SPIN_CAP) { atomicAdd(&bar[XB_TMO], 1u); break; } }
    }
    nloc = mine > 0u ? mine : 1u; nx = cnt > 0u ? cnt : 1u;
}

__device__ __forceinline__ void xcd_barrier(const XcdBarrier& b) {
    asm volatile("s_waitcnt vmcnt(0)" ::: "memory");
    __syncthreads();
    if (threadIdx.x == 0) {
        unsigned* bar = b.bar;
        __builtin_amdgcn_s_waitcnt(0);
        unsigned nloc = b.st[0], nx = b.st[1];
        if (nloc == 0u) { xcd_barrier_complete(bar, b.x, nloc, nx); b.st[0] = nloc; b.st[1] = nx; }
        const unsigned old = xb_add(&bar[XB_XSUB(b.x)], 1u);
        const unsigned gen = old / nloc;
        if (old + 1u == (gen + 1u) * nloc) {
            __builtin_amdgcn_fence(__ATOMIC_RELEASE, "agent");
            asm volatile("s_waitcnt vmcnt(0)" ::: "memory");
            const unsigned og = xb_add(&bar[XB_TOP], 1u);
            const unsigned tg = og / nx;
            if (og + 1u == (tg + 1u) * nx) xb_add(&bar[XB_TOPGEN], 1u);
            else XB_SPIN(xb_ld(&bar[XB_TOPGEN]) == tg, bar);
            __builtin_amdgcn_fence(__ATOMIC_ACQUIRE, "agent");
            xb_add(&bar[XB_XGEN(b.x)], 1u);
            asm volatile("s_waitcnt vmcnt(0)" ::: "memory");
        } else {
            XB_SPIN(xb_ld(&bar[XB_XGEN(b.x)]) == gen, bar);
            __builtin_amdgcn_fence(__ATOMIC_ACQUIRE, "agent");
            asm volatile("s_waitcnt vmcnt(0)" ::: "memory");
        }
    }
    __syncthreads();
}
constexpr int NWAVES = 8, NTHR = 512;
constexpr int T = 32768, SEQ = 2048, NBATCH = 16, D = 1024;
constexpr int NPROJ = 6656, INW = 6672;
constexpr float EPS = 1e-6f;
constexpr size_t MiB = 1u << 20;
constexpr size_t WS_CTL = 0, CTL_ZERO_BYTES = 64 * 1024;
constexpr size_t WS_GLR = 1 * MiB, WS_ROPE = 3 * MiB, WS_WIN = 4 * MiB, WS_WA = 18 * MiB, WS_WB = 20 * MiB, WS_WO = 22 * MiB, WS_WPQ = 24 * MiB, WS_SUBK = 28 * MiB;
constexpr size_t WS_H = 32 * MiB, WS_U = 32 * MiB, WS_V = 64 * MiB;
constexpr size_t WS_GQ = 96 * MiB, WS_GK = 128 * MiB, WS_GV = 160 * MiB, WS_GR = 224 * MiB, WS_SQ = 288 * MiB, WS_SK = 352 * MiB, WS_SV = 368 * MiB, WS_GA = 384 * MiB, WS_GB = 448 * MiB;
constexpr size_t WS_YA = 96 * MiB, WS_XN2 = 160 * MiB, WS_QP = 224 * MiB, WS_IDX = 352 * MiB, WS_GATE = 368 * MiB, WS_END = 512 * MiB;
constexpr int CW_BAR = 1024;
constexpr int LDS_BYTES = 163840, MISC_OFF = LDS_BYTES - 256;

typedef unsigned long long u64;
typedef float f32x16 __attribute__((ext_vector_type(16)));
typedef __bf16 bf2_t __attribute__((ext_vector_type(2)));
typedef LAS unsigned char* ldsp;

__device__ __forceinline__ float bf_lo(unsigned u) { return __builtin_bit_cast(float, u << 16); }
__device__ __forceinline__ float bf_hi(unsigned u) { return __builtin_bit_cast(float, u & 0xffff0000u); }
#define WS_DPP(x, ctrl, rm) __builtin_bit_cast(float, __builtin_amdgcn_update_dpp(0, __builtin_bit_cast(int, (x)), (ctrl), (rm), 0xf, false))
__device__ __forceinline__ float wave_sum(float v) {
    v += WS_DPP(v, 0x111, 0xf); v += WS_DPP(v, 0x112, 0xf); v += WS_DPP(v, 0x114, 0xf); v += WS_DPP(v, 0x118, 0xf);
    v += WS_DPP(v, 0x142, 0xa); v += WS_DPP(v, 0x143, 0xc);
    return __builtin_bit_cast(float, __builtin_amdgcn_readlane(__builtin_bit_cast(int, v), 63));
}
__device__ __forceinline__ float sigmoidf_(float x) { return 1.f / (1.f + __expf(-x)); }
__device__ __forceinline__ float logsigmoidf_(float z) { return fminf(z, 0.f) - __logf(1.f + __expf(-fabsf(z))); }

struct Frame {
    ldsp lds;
    unsigned char* ws; float* out;
    const float* in[17];
    int tid, lane, wave, vcu, G;
};

__device__ __forceinline__ void transpose_item(const float* W, int ldw, int src_col0, int valid_cols, int K, bf16* WT, int dst_row0, int nblk, LAS float* scr, int item, int lane) {
    const int kb = item / nblk, nb = item % nblk, k0 = 64 * kb, n0 = 32 * nb;
    const int nl = n0 + (lane & 31);
#pragma unroll 8
    for (int i = 0; i < 32; ++i) { const int kk = 2 * i + (lane >> 5); scr[kk * 33 + (lane & 31)] = (nl < valid_cols) ? W[(size_t)(k0 + kk) * ldw + src_col0 + nl] : 0.f; }
    LDS_WAIT(); asm volatile("" ::: "memory");
    const int c = lane & 7;
#pragma unroll
    for (int j = 0; j < 4; ++j) { const int n = (lane >> 3) + 8 * j; const LAS float* s = scr + (8 * c) * 33 + n;
        v4u o; o.x = pk2(s[0 * 33], s[1 * 33]); o.y = pk2(s[2 * 33], s[3 * 33]); o.z = pk2(s[4 * 33], s[5 * 33]); o.w = pk2(s[6 * 33], s[7 * 33]);
        *(GAS v4u*)(WT + (size_t)(dst_row0 + n0 + n) * K + k0 + 8 * c) = o; }
    LDS_WAIT(); asm volatile("" ::: "memory");
}
__device__ __forceinline__ void rms_row_to_bf16(int lane, const float* xrow, const float* g, bf16* orow) {
    const f32x4* xr = (const f32x4*)xrow + lane; const f32x4* gr = (const f32x4*)g + lane;
    f32x4 v[4]; float s = 0.f;
#pragma unroll
    for (int j = 0; j < 4; ++j) { v[j] = xr[64 * j]; s += (v[j].x * v[j].x + v[j].y * v[j].y) + (v[j].z * v[j].z + v[j].w * v[j].w); }
    const float rstd = 1.f / sqrtf(wave_sum(s) * (1.f / D) + EPS);
    u64* o8 = (u64*)orow + lane;
#pragma unroll
    for (int j = 0; j < 4; ++j) { const f32x4 gg = gr[64 * j];
        o8[64 * j] = (u64)pk2(v[j].x * rstd * gg.x, v[j].y * rstd * gg.y) | ((u64)pk2(v[j].z * rstd * gg.z, v[j].w * rstd * gg.w) << 32); }
}
__device__ __forceinline__ float xchg1(float v) { return __builtin_bit_cast(float, __builtin_amdgcn_update_dpp(0, __builtin_bit_cast(int, v), 0xB1, 0xf, 0xf, false)); }
__device__ __forceinline__ float xchg2(float v) { return __builtin_bit_cast(float, __builtin_amdgcn_update_dpp(0, __builtin_bit_cast(int, v), 0x4E, 0xf, 0xf, false)); }
__device__ __forceinline__ int r16_of_lane(int lane) { return ((lane >> 5) & 1) * 8 + ((lane >> 4) & 1) * 4 + ((lane >> 3) & 1) * 2 + ((lane >> 2) & 1); }
__device__ __forceinline__ float reduce16_t(const float* p, int lane) {
    float a[8], b[4], c[2];
    const bool h5 = (lane & 32) != 0, h4 = (lane & 16) != 0, h3 = (lane & 8) != 0, h2 = (lane & 4) != 0;
#pragma unroll
    for (int k = 0; k < 8; ++k) { const float keep = h5 ? p[k + 8] : p[k], send = h5 ? p[k] : p[k + 8]; a[k] = keep + __shfl_xor(send, 32); }
#pragma unroll
    for (int k = 0; k < 4; ++k) { const float keep = h4 ? a[k + 4] : a[k], send = h4 ? a[k] : a[k + 4]; b[k] = keep + __shfl_xor(send, 16); }
#pragma unroll
    for (int k = 0; k < 2; ++k) { const float keep = h3 ? b[k + 2] : b[k], send = h3 ? b[k] : b[k + 2]; c[k] = keep + __shfl_xor(send, 8); }
    float d = (h2 ? c[1] : c[0]) + __shfl_xor(h2 ? c[0] : c[1], 4);
    d += xchg2(d); d += xchg1(d);
    return d;
}
__device__ __forceinline__ void rms_row_glr(int lane, const float* xrow, const float* g, bf16* orow, const LAS float* WG, float* glr_out) {
    const f32x4* xr = (const f32x4*)xrow + lane; const f32x4* gr = (const f32x4*)g + lane;
    f32x4 v[4]; float s = 0.f;
#pragma unroll
    for (int j = 0; j < 4; ++j) { v[j] = xr[64 * j]; s += (v[j].x * v[j].x + v[j].y * v[j].y) + (v[j].z * v[j].z + v[j].w * v[j].w); }
    const float rstd = 1.f / sqrtf(wave_sum(s) * (1.f / D) + EPS);
    u64* o8 = (u64*)orow + lane;
#pragma unroll
    for (int j = 0; j < 4; ++j) { const f32x4 gg = gr[64 * j]; v[j].x *= rstd * gg.x; v[j].y *= rstd * gg.y; v[j].z *= rstd * gg.z; v[j].w *= rstd * gg.w;
        o8[64 * j] = (u64)pk2(v[j].x, v[j].y) | ((u64)pk2(v[j].z, v[j].w) << 32); }
    float p[16];
#pragma unroll
    for (int r = 0; r < 16; ++r) { float a = 0.f;
#pragma unroll
        for (int j = 0; j < 4; ++j) { const f32x4 wv = *(const LAS f32x4*)(WG + r * 1024 + 4 * lane + 256 * j); a += (v[j].x * wv.x + v[j].y * wv.y) + (v[j].z * wv.z + v[j].w * wv.w); }
        p[r] = a; if ((r & 3) == 3) __builtin_amdgcn_sched_barrier(0); }
    const float tot = reduce16_t(p, lane);
    if ((lane & 3) == 0) glr_out[r16_of_lane(lane)] = tot;
}
__device__ __forceinline__ void cvt_rows_bf16(const float* src, bf16* dst, size_t n8, size_t gtid, size_t gthreads) {
    for (size_t i = gtid; i < n8; i += gthreads) { const f32x4 a = ((const f32x4*)src)[2 * i], b = ((const f32x4*)src)[2 * i + 1];
        v4u o; o.x = pk2(a.x, a.y); o.y = pk2(a.z, a.w); o.z = pk2(b.x, b.y); o.w = pk2(b.z, b.w); ((v4u*)dst)[i] = o; }
}
__device__ __forceinline__ void p0_prologue(Frame& F) {
    LAS float* scr = (LAS float*)(F.lds + F.wave * 16384);
    const int gw = F.vcu * NWAVES + F.wave, NGW = F.G * NWAVES;
    const float* w_in = F.in[2];
    constexpr int I1 = 16 * 96, I2 = 16 * 112, I4 = 16 * 32, I7 = 16 * 64;
    constexpr int NITEMS = I1 + I2 + 3 * I4 + I7;
    for (int it = gw; it < NITEMS; it += NGW) {
        int r = it;
        if (r < I1) { transpose_item(w_in, INW, 0, 3072, D, (bf16*)(F.ws + WS_WIN), 0, 96, scr, r, F.lane); continue; } r -= I1;
        if (r < I2) { transpose_item(w_in, INW, 3088, 3584, D, (bf16*)(F.ws + WS_WIN), 3072, 112, scr, r, F.lane); continue; } r -= I2;
        if (r < I4) { transpose_item(F.in[9], D, 0, D, D, (bf16*)(F.ws + WS_WA), 0, 32, scr, r, F.lane); continue; } r -= I4;
        if (r < I4) { transpose_item(F.in[10], D, 0, D, D, (bf16*)(F.ws + WS_WB), 0, 32, scr, r, F.lane); continue; } r -= I4;
        if (r < I4) { transpose_item(F.in[11], D, 0, D, D, (bf16*)(F.ws + WS_WO), 0, 32, scr, r, F.lane); continue; } r -= I4;
        transpose_item(F.in[13], 2048, 0, 2048, D, (bf16*)(F.ws + WS_WPQ), 0, 64, scr, r, F.lane);
    }
    __syncthreads();
    { LAS float* WG = (LAS float*)F.lds;
      for (int i = F.tid; i < 16 * 1024; i += NTHR) { const int k = i >> 4, r = i & 15; WG[r * 1024 + k] = w_in[(size_t)k * INW + 3072 + r]; }
      __syncthreads();
      for (int m = gw; m < T; m += NGW) rms_row_glr(F.lane, F.in[0] + (size_t)m * D, F.in[1], (bf16*)(F.ws + WS_H) + (size_t)m * D, WG, (float*)(F.ws + WS_GLR) + (size_t)m * 16); }
    const size_t gtid = (size_t)F.vcu * NTHR + F.tid, gthreads = (size_t)F.G * NTHR;
    cvt_rows_bf16(F.in[14], (bf16*)(F.ws + WS_SUBK), (size_t)(8 * 2 * 128 * 128) / 8, gtid, gthreads);
    if (gtid < (size_t)SEQ * 8) {
        const double invf[8] = {1.0, 0.19392274474868576, 0.03760603093086393, 0.007292664737217109, 0.001414213562373095, 0.0002742481756762073, 5.318295896944988e-05, 1.031338537721246e-05};
        const int pos = (int)(gtid >> 3), j = (int)(gtid & 7);
        double iv = invf[0];
#pragma unroll
        for (int q = 1; q < 8; ++q) iv = (j == q) ? invf[q] : iv;
        const float angf = (float)pos * (float)iv;
        const double rev = (double)angf * 0.15915494309189535;
        const double fr = rev - floor(rev);
        const float f = (float)fr;
        float2 cs; cs.x = __builtin_amdgcn_cosf(f); cs.y = __builtin_amdgcn_sinf(f);
        ((float2*)(F.ws + WS_ROPE))[gtid] = cs;
    }
}
template <int MODE> struct EpiB {
    static constexpr bool PERM = true, AFTER_DRAIN = false;
    unsigned char* ws;
    __device__ __forceinline__ void operator()(const pg8::f32x4 (&acc)[2][2][4][2], const pg8::Unit& u, int wr, int wc, int fr, int fq) const {
        using namespace pg8;
        const int row0 = u.pm * BM + wr * 64 + fr;
        bf16_t* base; int ldc, colt, act = 0; const bf16_t* gate = nullptr;
        if (MODE == 0) {
            const int pn = u.pn;
            if (pn == 26) {
                if (wc == 0 && fq < 2) { float* G = (float*)(ws + WS_GLR);
#pragma unroll
                    for (int ai = 0; ai < 2; ++ai)
#pragma unroll
                        for (int m = 0; m < 4; ++m) { float* rp = G + (size_t)(row0 + ai * HALF + m * 16) * 16 + 8 * fq; *(f32x4*)rp = acc[ai][0][m][0]; *(f32x4*)(rp + 4) = acc[ai][0][m][1]; } }
                return;
            }
            size_t off;
            if (pn < 2) { off = WS_GQ; ldc = 512; colt = pn * 256; }
            else if (pn < 4) { off = WS_GK; ldc = 512; colt = (pn - 2) * 256; }
            else if (pn < 8) { off = WS_GV; ldc = 1024; colt = (pn - 4) * 256; }
            else if (pn < 12) { off = WS_GR; ldc = 1024; colt = (pn - 8) * 256; act = 1; }
            else if (pn < 16) { off = WS_SQ; ldc = 1024; colt = (pn - 12) * 256; }
            else if (pn < 17) { off = WS_SK; ldc = 256; colt = 0; }
            else if (pn < 18) { off = WS_SV; ldc = 256; colt = 0; }
            else if (pn < 22) { off = WS_GA; ldc = 1024; colt = (pn - 18) * 256; act = 2; }
            else { off = WS_GB; ldc = 1024; colt = (pn - 22) * 256; act = 2; }
            base = (bf16_t*)(ws + off);
        } else if (MODE == 1) { base = (bf16_t*)(ws + WS_YA); ldc = 1024; colt = u.pn * BM; gate = (const bf16_t*)(ws + WS_GA); }
        else if (MODE == 2) { base = (bf16_t*)(ws + WS_YA); ldc = 1024; colt = u.pn * BM; gate = (const bf16_t*)(ws + WS_GB); }
        else { base = (bf16_t*)(ws + WS_QP); ldc = 2048; colt = u.pn * BM; }
        const int col0 = colt + wc * 32 + 8 * fq;
#pragma unroll
        for (int ai = 0; ai < 2; ++ai)
#pragma unroll
            for (int m = 0; m < 4; ++m) { const size_t ro = (size_t)(row0 + ai * HALF + m * 16) * ldc + col0;
#pragma unroll
                for (int bj = 0; bj < 2; ++bj) { f32x4 v0 = acc[ai][bj][m][0], v1 = acc[ai][bj][m][1];
                    if (MODE == 0) {
                        if (act == 1) {
#pragma unroll
                            for (int e = 0; e < 4; ++e) { v0[e] = v0[e] * sigmoidf_(v0[e]); v1[e] = v1[e] * sigmoidf_(v1[e]); } }
                        else if (act == 2) {
#pragma unroll
                            for (int e = 0; e < 4; ++e) { v0[e] = sigmoidf_(v0[e]); v1[e] = sigmoidf_(v1[e]); } }
                    }
                    if (MODE == 1 || MODE == 2) {
                        const u32x4 gv = *(const u32x4*)(gate + ro + bj * HALF);
                        v0[0] *= bf_lo(gv.x); v0[1] *= bf_hi(gv.x); v0[2] *= bf_lo(gv.y); v0[3] *= bf_hi(gv.y);
                        v1[0] *= bf_lo(gv.z); v1[1] *= bf_hi(gv.z); v1[2] *= bf_lo(gv.w); v1[3] *= bf_hi(gv.w);
                        if (MODE == 2) { const u32x4 yv = *(const u32x4*)(base + ro + bj * HALF);
                            v0[0] += bf_lo(yv.x); v0[1] += bf_hi(yv.x); v0[2] += bf_lo(yv.y); v0[3] += bf_hi(yv.y);
                            v1[0] += bf_lo(yv.z); v1[1] += bf_hi(yv.z); v1[2] += bf_lo(yv.w); v1[3] += bf_hi(yv.w); }
                    }
                    u32x4 w; w.x = cvt_pk_bf16(v0[0], v0[1]); w.y = cvt_pk_bf16(v0[2], v0[3]); w.z = cvt_pk_bf16(v1[0], v1[1]); w.w = cvt_pk_bf16(v1[2], v1[3]);
                    *(u32x4*)(base + ro + bj * HALF) = w; } }
    }
};
struct EpiX1 {
    static constexpr bool PERM = false, AFTER_DRAIN = false;
    const float* x; float* out;
    __device__ __forceinline__ void operator()(const pg8::f32x4 (&acc)[2][2][4][2], const pg8::Unit& u, int wr, int wc, int fr, int fq) const {
        using namespace pg8;
        const int row0 = u.pm * BM + wr * 64 + fr, col0 = u.pn * BM + wc * 32 + 4 * fq;
#pragma unroll
        for (int ai = 0; ai < 2; ++ai)
#pragma unroll
            for (int m = 0; m < 4; ++m) { const size_t ro = (size_t)(row0 + ai * HALF + m * 16) * D + col0;
#pragma unroll
                for (int bj = 0; bj < 2; ++bj)
#pragma unroll
                    for (int n = 0; n < 2; ++n) { const size_t o = ro + bj * HALF + n * 16; *(f32x4*)(out + o) = *(const f32x4*)(x + o) + acc[ai][bj][m][n]; } }
    }
};
constexpr int GL_QT = 0, GL_KT = 17408, GL_KTT = 34816, GL_VT = 53248, GL_ATT = 90112, GL_BC = 99328, GL_SEG = 132096, GL_EREF = 134144, GL_ELAST = 134656, GL_GLR = 135168, GL_END = 139264;
constexpr int GL_OST = 0;
static_assert(GL_END <= MISC_OFF, "gla lds");
__device__ __forceinline__ pg8::bf16x8 mk8(u64 lo, u64 hi) { pg8::u32x4 v; v.x = (unsigned)lo; v.y = (unsigned)(lo >> 32); v.z = (unsigned)hi; v.w = (unsigned)(hi >> 32); return __builtin_bit_cast(pg8::bf16x8, v); }
#define LBAR() do { asm volatile("s_waitcnt lgkmcnt(0)" ::: "memory"); __builtin_amdgcn_s_barrier(); asm volatile("" ::: "memory"); } while (0)
constexpr size_t WS_EG = WS_WIN;
struct PreRegs { pg8::u32x4 q0, q1, k0, k1, v0a, v0b, v1a, v1b; pg8::f32x4 gl; };
__device__ __forceinline__ void gla_pre_load(Frame& F, int u, PreRegs& r) {
    using pg8::u32x4; using pg8::f32x4;
    const int b = u >> 7, h = (u >> 5) & 3, n = u & 31, tid = F.tid, tp = tid >> 4, dg = tid & 15, t0 = 2 * tp, d0 = 8 * dg, e0 = 16 * dg;
    const size_t rowbase = (size_t)b * SEQ + n * 64;
    const bf16* qp0 = (const bf16*)(F.ws + WS_GQ) + (rowbase + t0) * 512 + h * 128 + d0; const bf16* kp0 = (const bf16*)(F.ws + WS_GK) + (rowbase + t0) * 512 + h * 128 + d0;
    const bf16* GV = (const bf16*)(F.ws + WS_GV);
    r.q0 = *(const u32x4*)qp0; r.q1 = *(const u32x4*)(qp0 + 512); r.k0 = *(const u32x4*)kp0; r.k1 = *(const u32x4*)(kp0 + 512);
    r.v0a = *(const u32x4*)(GV + (rowbase + t0) * 1024 + h * 256 + e0); r.v0b = *(const u32x4*)(GV + (rowbase + t0) * 1024 + h * 256 + e0 + 8);
    r.v1a = *(const u32x4*)(GV + (rowbase + t0 + 1) * 1024 + h * 256 + e0); r.v1b = *(const u32x4*)(GV + (rowbase + t0 + 1) * 1024 + h * 256 + e0 + 8);
    if (tid < 256) r.gl = *(const f32x4*)((const float*)(F.ws + WS_GLR) + (rowbase + (tid >> 2)) * 16 + (tid & 3) * 4);
}
__device__ __forceinline__ void gla_pre_unit(Frame& F, int b, int h, int n, const PreRegs& R) {
    using pg8::u32x4; using pg8::f32x4;
    const ldsp L = F.lds; const int tid = F.tid;
    bf16* GQ = (bf16*)(F.ws + WS_GQ); bf16* GK = (bf16*)(F.ws + WS_GK); const float* GLR = (const float*)(F.ws + WS_GLR);
    float* EG = (float*)(F.ws + WS_EG) + (size_t)((b * 4 + h) * 32 + n) * 256;
    const float* w2 = F.in[3]; const float* bgk = F.in[4];
    const int dch = tid & 127, sg = tid >> 7;
    float w2c[16];
#pragma unroll
    for (int r = 0; r < 16; ++r) w2c[r] = w2[r * 512 + h * 128 + dch];
    const float bias = bgk[h * 128 + dch];
    const int tp = tid >> 4, dg = tid & 15, t0 = 2 * tp, d0 = 8 * dg;
    const float qscale = 0.08838834764831845f;
    const size_t rowbase = (size_t)b * SEQ + n * 64;
    bf16* qp0 = GQ + (rowbase + t0) * 512 + h * 128 + d0; bf16* kp0 = GK + (rowbase + t0) * 512 + h * 128 + d0;
    const u32x4 q0 = R.q0, q1 = R.q1, k0 = R.k0, k1 = R.k1, v0a = R.v0a, v0b = R.v0b, v1a = R.v1a, v1b = R.v1b; const int e0 = 16 * dg;
    (void)GLR;
    if (tid < 256) { *(LAS f32x4*)(L + GL_GLR + tid * 16) = R.gl; }
    LBAR();
    {
        float run = 0.f;
#pragma unroll 4
        for (int tt = 0; tt < 16; ++tt) { const int t = 16 * sg + tt; const LAS float* gl = (const LAS float*)(L + GL_GLR + t * 64);
            float z = bias;
#pragma unroll
            for (int r = 0; r < 16; ++r) z += gl[r] * w2c[r];
            run += logsigmoidf_(z) * (1.f / 16.f);
            ((LAS float*)(L + GL_BC))[t * 128 + dch] = run; }
        ((LAS float*)(L + GL_SEG))[sg * 128 + dch] = run;
    }
    LBAR();
    {
        const LAS float* BC = (const LAS float*)(L + GL_BC); const LAS float* SG = (const LAS float*)(L + GL_SEG);
        const int sgt = t0 >> 4;
        float qs0[8], qs1[8], ks0[8], ks1[8];
        const unsigned qa[4] = {q0.x, q0.y, q0.z, q0.w}, qb[4] = {q1.x, q1.y, q1.z, q1.w}, ka[4] = {k0.x, k0.y, k0.z, k0.w}, kb[4] = {k1.x, k1.y, k1.z, k1.w};
#pragma unroll
        for (int j = 0; j < 8; ++j) { const int d = d0 + j;
            const float s0 = SG[d], s1 = SG[128 + d], s2 = SG[256 + d];
            const float pre = (sgt > 0 ? s0 : 0.f) + (sgt > 1 ? s1 : 0.f) + (sgt > 2 ? s2 : 0.f);
            const float bref = BC[32 * 128 + d] + s0 + s1;
            const float b0 = BC[t0 * 128 + d] + pre - bref, b1 = BC[(t0 + 1) * 128 + d] + pre - bref;
            const float e0q = __expf(b0), e1q = __expf(b1), e0k = __expf(-b0), e1k = __expf(-b1);
            const float qv0 = (j & 1) ? bf_hi(qa[j >> 1]) : bf_lo(qa[j >> 1]), qv1 = (j & 1) ? bf_hi(qb[j >> 1]) : bf_lo(qb[j >> 1]);
            const float kv0 = (j & 1) ? bf_hi(ka[j >> 1]) : bf_lo(ka[j >> 1]), kv1 = (j & 1) ? bf_hi(kb[j >> 1]) : bf_lo(kb[j >> 1]);
            qs0[j] = qv0 * qscale * e0q; qs1[j] = qv1 * qscale * e1q; ks0[j] = kv0 * e0k; ks1[j] = kv1 * e1k; }
        u32x4 o;
        o.x = pk2(qs0[0], qs0[1]); o.y = pk2(qs0[2], qs0[3]); o.z = pk2(qs0[4], qs0[5]); o.w = pk2(qs0[6], qs0[7]); *(u32x4*)qp0 = o; *(LAS u32x4*)(L + GL_QT + t0 * 272 + d0 * 2) = o;
        o.x = pk2(qs1[0], qs1[1]); o.y = pk2(qs1[2], qs1[3]); o.z = pk2(qs1[4], qs1[5]); o.w = pk2(qs1[6], qs1[7]); *(u32x4*)(qp0 + 512) = o; *(LAS u32x4*)(L + GL_QT + (t0 + 1) * 272 + d0 * 2) = o;
        o.x = pk2(ks0[0], ks0[1]); o.y = pk2(ks0[2], ks0[3]); o.z = pk2(ks0[4], ks0[5]); o.w = pk2(ks0[6], ks0[7]); *(u32x4*)kp0 = o; *(LAS u32x4*)(L + GL_KT + t0 * 272 + d0 * 2) = o;
        o.x = pk2(ks1[0], ks1[1]); o.y = pk2(ks1[2], ks1[3]); o.z = pk2(ks1[4], ks1[5]); o.w = pk2(ks1[6], ks1[7]); *(u32x4*)(kp0 + 512) = o; *(LAS u32x4*)(L + GL_KT + (t0 + 1) * 272 + d0 * 2) = o;
        { const unsigned va[8] = {v0a.x, v0a.y, v0a.z, v0a.w, v0b.x, v0b.y, v0b.z, v0b.w}, vb[8] = {v1a.x, v1a.y, v1a.z, v1a.w, v1b.x, v1b.y, v1b.z, v1b.w};
#pragma unroll
          for (int j = 0; j < 16; ++j) { const unsigned a = va[j >> 1], c = vb[j >> 1];
              const unsigned pk = (j & 1) ? ((a >> 16) | (c & 0xffff0000u)) : ((a & 0xffffu) | (c << 16));
              *(LAS unsigned*)(L + GL_VT + (e0 + j) * 144 + (((tp >> 2) ^ (dg & 7)) << 4) + ((tp & 3) << 2)) = pk; } }
        if (tid < 128) { const int d = tid; const float s0 = SG[d], s1 = SG[128 + d], s2 = SG[256 + d];
            const float bref = BC[32 * 128 + d] + s0 + s1, blast = BC[63 * 128 + d] + s0 + s1 + s2;
            EG[d] = __expf(bref); EG[128 + d] = __expf(blast - bref); }
    }
    LBAR();
    {
        using pg8::bf16x8; const int lane = F.lane, w = F.wave, l16 = lane & 15, g4 = lane >> 4; const int tt4 = w >> 1;
#pragma unroll
        for (int q = 0; q < 2; ++q) { const int st4 = 2 * (w & 1) + q; f32x4 a4 = {0.f, 0.f, 0.f, 0.f};
#pragma unroll
            for (int ks = 0; ks < 4; ++ks) { const bf16x8 A = *(const LAS bf16x8*)(L + GL_QT + (16 * tt4 + l16) * 272 + (32 * ks + 8 * g4) * 2), Bk = *(const LAS bf16x8*)(L + GL_KT + (16 * st4 + l16) * 272 + (32 * ks + 8 * g4) * 2);
                a4 = __builtin_amdgcn_mfma_f32_16x16x32_bf16(A, Bk, a4, 0, 0, 0); }
#pragma unroll
            for (int i = 0; i < 4; ++i) { const int t = 16 * tt4 + 4 * g4 + i, s_ = 16 * st4 + l16; const float v = (s_ <= t) ? a4[i] : 0.f;
                *(LAS unsigned short*)(L + GL_ATT + t * 144 + s_ * 2) = (unsigned short)f2bf(v); } }
    }
    LBAR();
    {
        using pg8::bf16x8; const int lane = F.lane, w = F.wave, hb = lane >> 5, l32 = lane & 31;
        f32x16 oacc[2];
#pragma unroll
        for (int i = 0; i < 16; ++i) { oacc[0][i] = 0.f; oacc[1][i] = 0.f; }
#pragma unroll
        for (int ks = 0; ks < 4; ++ks) { const bf16x8 Bv = *(const LAS bf16x8*)(L + GL_VT + (32 * w + l32) * 144 + (((2 * ks + hb) ^ (((32 * w + l32) >> 4) & 7)) << 4));
#pragma unroll
            for (int tt = 0; tt < 2; ++tt) { const bf16x8 A = *(const LAS bf16x8*)(L + GL_ATT + (32 * tt + l32) * 144 + (16 * ks + 8 * hb) * 2);
                oacc[tt] = __builtin_amdgcn_mfma_f32_32x32x16_bf16(A, Bv, oacc[tt], 0, 0, 0); } }
        const int P = w * 64 + lane; bf16* pp = (bf16*)F.out + (rowbase + (P >> 3)) * 1024 + h * 256 + (P & 7) * 32;
#pragma unroll
        for (int tt = 0; tt < 2; ++tt)
#pragma unroll
            for (int c = 0; c < 2; ++c) { u32x4 o; o.x = pk2(oacc[tt][8 * c + 0], oacc[tt][8 * c + 1]); o.y = pk2(oacc[tt][8 * c + 2], oacc[tt][8 * c + 3]); o.z = pk2(oacc[tt][8 * c + 4], oacc[tt][8 * c + 5]); o.w = pk2(oacc[tt][8 * c + 6], oacc[tt][8 * c + 7]);
                *(u32x4*)(pp + 16 * tt + 8 * c) = o; }
    }
}
__device__ __forceinline__ void gla_unit(Frame& F, int b, int h) {
    using pg8::bf16x8; using pg8::u32x4; using pg8::f32x4;
    const ldsp L = F.lds; const int tid = F.tid, lane = F.lane, w = F.wave, hb = lane >> 5, l32 = lane & 31;
    const bf16* GQ = (const bf16*)(F.ws + WS_GQ); const bf16* GK = (const bf16*)(F.ws + WS_GK); const bf16* GV = (const bf16*)(F.ws + WS_GV);
    const float* EG = (const float*)(F.ws + WS_EG) + (size_t)((b * 4 + h) * 32) * 256; bf16* OA = (bf16*)F.out;
    f32x16 st[4];
#pragma unroll
    for (int dt = 0; dt < 4; ++dt)
#pragma unroll
        for (int i = 0; i < 16; ++i) st[dt][i] = 0.f;
    const int tp = tid >> 4, dg = tid & 15, t0 = 2 * tp, d0 = 8 * dg, e0 = 16 * dg;
    const int P = w * 64 + lane;
    u32x4 q0, q1, k0, k1, v0a, v0b, v1a, v1b, oi[4]; float egv = 0.f;
#define GLA_PREFETCH(nn) do { const size_t rb_ = (size_t)b * SEQ + (nn) * 64; \
        q0 = *(const u32x4*)(GQ + (rb_ + t0) * 512 + h * 128 + d0); q1 = *(const u32x4*)(GQ + (rb_ + t0 + 1) * 512 + h * 128 + d0); \
        k0 = *(const u32x4*)(GK + (rb_ + t0) * 512 + h * 128 + d0); k1 = *(const u32x4*)(GK + (rb_ + t0 + 1) * 512 + h * 128 + d0); \
        v0a = *(const u32x4*)(GV + (rb_ + t0) * 1024 + h * 256 + e0); v0b = *(const u32x4*)(GV + (rb_ + t0) * 1024 + h * 256 + e0 + 8); \
        v1a = *(const u32x4*)(GV + (rb_ + t0 + 1) * 1024 + h * 256 + e0); v1b = *(const u32x4*)(GV + (rb_ + t0 + 1) * 1024 + h * 256 + e0 + 8); \
        { const u32x4* pp_ = (const u32x4*)(OA + (rb_ + (P >> 3)) * 1024 + h * 256 + (P & 7) * 32); oi[0] = pp_[0]; oi[1] = pp_[1]; oi[2] = pp_[2]; oi[3] = pp_[3]; } \
        if (tid < 256) egv = EG[(nn) * 256 + tid]; } while (0)
    GLA_PREFETCH(0);
    for (int n = 0; n < 32; ++n) {
        const size_t rowbase = (size_t)b * SEQ + n * 64;
        LBAR();
        {
            *(LAS u32x4*)(L + GL_QT + t0 * 272 + d0 * 2) = q0; *(LAS u32x4*)(L + GL_QT + (t0 + 1) * 272 + d0 * 2) = q1;
            const unsigned ka[4] = {k0.x, k0.y, k0.z, k0.w}, kb[4] = {k1.x, k1.y, k1.z, k1.w};
#pragma unroll
            for (int j = 0; j < 8; ++j) { const unsigned a = ka[j >> 1], c = kb[j >> 1];
                const unsigned pk = (j & 1) ? ((a >> 16) | (c & 0xffff0000u)) : ((a & 0xffffu) | (c << 16));
                *(LAS unsigned*)(L + GL_KTT + (d0 + j) * 144 + (((tp >> 2) ^ (dg & 7)) << 4) + ((tp & 3) << 2)) = pk; }
            const unsigned va[8] = {v0a.x, v0a.y, v0a.z, v0a.w, v0b.x, v0b.y, v0b.z, v0b.w}, vb[8] = {v1a.x, v1a.y, v1a.z, v1a.w, v1b.x, v1b.y, v1b.z, v1b.w};
#pragma unroll
            for (int j = 0; j < 16; ++j) { const unsigned a = va[j >> 1], c = vb[j >> 1];
                const unsigned pk = (j & 1) ? ((a >> 16) | (c & 0xffff0000u)) : ((a & 0xffffu) | (c << 16));
                *(LAS unsigned*)(L + GL_VT + (e0 + j) * 144 + (((tp >> 2) ^ (dg & 7)) << 4) + ((tp & 3) << 2)) = pk; }
            if (tid < 256) ((LAS float*)(L + GL_EREF))[tid] = egv;
        }
        f32x16 oacc[2];
#pragma unroll
        for (int tt = 0; tt < 2; ++tt)
#pragma unroll
            for (int c = 0; c < 2; ++c) { const u32x4 pv = oi[2 * tt + c];
                oacc[tt][8 * c + 0] = bf_lo(pv.x); oacc[tt][8 * c + 1] = bf_hi(pv.x); oacc[tt][8 * c + 2] = bf_lo(pv.y); oacc[tt][8 * c + 3] = bf_hi(pv.y);
                oacc[tt][8 * c + 4] = bf_lo(pv.z); oacc[tt][8 * c + 5] = bf_hi(pv.z); oacc[tt][8 * c + 6] = bf_lo(pv.w); oacc[tt][8 * c + 7] = bf_hi(pv.w); }
        if (n + 1 < 32) GLA_PREFETCH(n + 1);
        LBAR();
        {
            const LAS float* ER = (const LAS float*)(L + GL_EREF);
#pragma unroll
            for (int dt = 0; dt < 4; ++dt) {
#pragma unroll
                for (int q = 0; q < 4; ++q) { const f32x4 e4 = *(const LAS f32x4*)(ER + 32 * dt + 8 * q + 4 * hb); st[dt][4 * q] *= e4.x; st[dt][4 * q + 1] *= e4.y; st[dt][4 * q + 2] *= e4.z; st[dt][4 * q + 3] *= e4.w; }
#pragma unroll
                for (int ks = 0; ks < 2; ++ks) {
                    u32x4 bb; bb.x = pk2(st[dt][8 * ks + 0], st[dt][8 * ks + 1]); bb.y = pk2(st[dt][8 * ks + 2], st[dt][8 * ks + 3]); bb.z = pk2(st[dt][8 * ks + 4], st[dt][8 * ks + 5]); bb.w = pk2(st[dt][8 * ks + 6], st[dt][8 * ks + 7]);
                    const bf16x8 B = __builtin_bit_cast(bf16x8, bb);
#pragma unroll
                    for (int tt = 0; tt < 2; ++tt) { const int t = 32 * tt + l32; const int dbase = 32 * dt + 16 * ks + 4 * hb;
                        const u64 lo = *(const LAS u64*)(L + GL_QT + t * 272 + dbase * 2), hi = *(const LAS u64*)(L + GL_QT + t * 272 + (dbase + 8) * 2);
                        oacc[tt] = __builtin_amdgcn_mfma_f32_32x32x16_bf16(mk8(lo, hi), B, oacc[tt], 0, 0, 0); }
                }
            }
        }
        { bf16* pp = OA + (rowbase + (P >> 3)) * 1024 + h * 256 + (P & 7) * 32;
#pragma unroll
          for (int tt = 0; tt < 2; ++tt)
#pragma unroll
            for (int c = 0; c < 2; ++c) { u32x4 o; o.x = pk2(oacc[tt][8 * c + 0], oacc[tt][8 * c + 1]); o.y = pk2(oacc[tt][8 * c + 2], oacc[tt][8 * c + 3]); o.z = pk2(oacc[tt][8 * c + 4], oacc[tt][8 * c + 5]); o.w = pk2(oacc[tt][8 * c + 6], oacc[tt][8 * c + 7]);
                *(u32x4*)(pp + 16 * tt + 8 * c) = o; } }
        {
            bf16x8 Bv[4];
#pragma unroll
            for (int ks = 0; ks < 4; ++ks) Bv[ks] = *(const LAS bf16x8*)(L + GL_VT + (32 * w + l32) * 144 + (((2 * ks + hb) ^ (((32 * w + l32) >> 4) & 7)) << 4));
            const LAS float* EL = (const LAS float*)(L + GL_ELAST);
#pragma unroll
            for (int dt = 0; dt < 4; ++dt) {
#pragma unroll
                for (int ks = 0; ks < 4; ++ks) { const bf16x8 A = *(const LAS bf16x8*)(L + GL_KTT + (32 * dt + l32) * 144 + (((2 * ks + hb) ^ (((32 * dt + l32) >> 3) & 7)) << 4));
                    st[dt] = __builtin_amdgcn_mfma_f32_32x32x16_bf16(A, Bv[ks], st[dt], 0, 0, 0); }
#pragma unroll
                for (int q = 0; q < 4; ++q) { const f32x4 e4 = *(const LAS f32x4*)(EL + 32 * dt + 8 * q + 4 * hb); st[dt][4 * q] *= e4.x; st[dt][4 * q + 1] *= e4.y; st[dt][4 * q + 2] *= e4.z; st[dt][4 * q + 3] *= e4.w; }
            }
        }
    }
#undef GLA_PREFETCH
}
__device__ __forceinline__ void gla_post_unit(Frame& F, int b, int h, int n) {
    using pg8::u32x4; using pg8::f32x4;
    const ldsp L = F.lds; const int tid = F.tid, lane = F.lane, w = F.wave, hb = lane >> 5, l32 = lane & 31;
    const bf16* GR = (const bf16*)(F.ws + WS_GR); bf16* OA = (bf16*)F.out; const float* gng = F.in[5];
    const size_t rowbase = (size_t)b * SEQ + n * 64;
    const int P = tid; const u32x4* pp = (const u32x4*)(OA + (rowbase + (P >> 3)) * 1024 + h * 256 + (P & 7) * 32);
    const u32x4 pv[4] = {pp[0], pp[1], pp[2], pp[3]};
    const int et = tid >> 3, ec = tid & 7, ee = 32 * ec;
    u32x4 grv[4];
    { const bf16* grp = GR + (rowbase + et) * 1024 + h * 256 + ee;
#pragma unroll
      for (int j2 = 0; j2 < 4; ++j2) grv[j2] = *(const u32x4*)(grp + 8 * j2); }
    LBAR();
#pragma unroll
    for (int tt = 0; tt < 2; ++tt)
#pragma unroll
        for (int c = 0; c < 2; ++c) { const u32x4 x = pv[2 * tt + c]; const unsigned xs[4] = {x.x, x.y, x.z, x.w};
#pragma unroll
            for (int q = 0; q < 4; ++q) { const int i0 = 8 * c + 2 * q;
                ((LAS float*)(L + GL_OST))[(32 * tt + 8 * (i0 >> 2) + 4 * hb + (i0 & 3)) * 260 + 32 * w + l32] = bf_lo(xs[q]);
                ((LAS float*)(L + GL_OST))[(32 * tt + 8 * ((i0 + 1) >> 2) + 4 * hb + ((i0 + 1) & 3)) * 260 + 32 * w + l32] = bf_hi(xs[q]); } }
    LBAR();
    {
        f32x4 ov[8]; float ss = 0.f;
#pragma unroll
        for (int j = 0; j < 8; ++j) { ov[j] = *(const LAS f32x4*)(L + GL_OST + (et * 260 + ee + 4 * j) * 4); ss += (ov[j].x * ov[j].x + ov[j].y * ov[j].y) + (ov[j].z * ov[j].z + ov[j].w * ov[j].w); }
        ss += xchg1(ss); ss += xchg2(ss); ss += __shfl_xor(ss, 4);
        const float rstd = 1.f / sqrtf(ss * (1.f / 256.f) + EPS);
        bf16* op = OA + (rowbase + et) * 1024 + h * 256 + ee;
#pragma unroll
        for (int j2 = 0; j2 < 4; ++j2) { const u32x4 gv = grv[j2]; const f32x4 g0 = *(const f32x4*)(gng + ee + 8 * j2), g1 = *(const f32x4*)(gng + ee + 8 * j2 + 4);
            const f32x4 a = ov[2 * j2], c2 = ov[2 * j2 + 1]; u32x4 o;
            o.x = pk2(a.x * rstd * g0.x * bf_lo(gv.x), a.y * rstd * g0.y * bf_hi(gv.x)); o.y = pk2(a.z * rstd * g0.z * bf_lo(gv.y), a.w * rstd * g0.w * bf_hi(gv.y));
            o.z = pk2(c2.x * rstd * g1.x * bf_lo(gv.z), c2.y * rstd * g1.y * bf_hi(gv.z)); o.w = pk2(c2.z * rstd * g1.z * bf_lo(gv.w), c2.w * rstd * g1.w * bf_hi(gv.w));
            *(u32x4*)(op + 8 * j2) = o; }
    }
}
constexpr int SW_KS = 0, SW_VT = 36864, SW_QS = 36864 + 33792, SW_END = SW_QS + 18432;
static_assert(SW_END <= MISC_OFF, "swa lds");
__device__ __forceinline__ void swa_unit(Frame& F, int b, int qb, int kvh) {
    using pg8::bf16x8; using pg8::u32x4; using pg8::f32x4;
    const ldsp L = F.lds; const int tid = F.tid, lane = F.lane, w = F.wave, l16 = lane & 15, g4 = lane >> 4;
    const bf16* SQ = (const bf16*)(F.ws + WS_SQ); const bf16* SK = (const bf16*)(F.ws + WS_SK); const bf16* SV = (const bf16*)(F.ws + WS_SV);
    const float2* ROPE = (const float2*)(F.ws + WS_ROPE); bf16* OB = (bf16*)F.out + (size_t)T * D;
    const float* qng = F.in[6]; const float* kng = F.in[7]; const float* sinks = F.in[8];
    __syncthreads();
    {
        const int key = tid >> 1, half = tid & 1; const int pos = (qb - 1) * 128 + key;
        float x[32];
        if (pos >= 0) { const u32x4* src = (const u32x4*)(SK + ((size_t)b * SEQ + pos) * 256 + kvh * 64 + 32 * half);
#pragma unroll
            for (int j = 0; j < 4; ++j) { const u32x4 v = src[j]; x[8 * j + 0] = bf_lo(v.x); x[8 * j + 1] = bf_hi(v.x); x[8 * j + 2] = bf_lo(v.y); x[8 * j + 3] = bf_hi(v.y); x[8 * j + 4] = bf_lo(v.z); x[8 * j + 5] = bf_hi(v.z); x[8 * j + 6] = bf_lo(v.w); x[8 * j + 7] = bf_hi(v.w); } }
        else {
#pragma unroll
            for (int j = 0; j < 32; ++j) x[j] = 0.f; }
        float ss = 0.f;
#pragma unroll
        for (int j = 0; j < 32; ++j) ss += x[j] * x[j];
        ss += __shfl_xor(ss, 1);
        const float rstd = 1.f / sqrtf(ss * (1.f / 64.f) + EPS);
#pragma unroll
        for (int j = 0; j < 32; ++j) x[j] = x[j] * rstd * kng[32 * half + j];
        if (half == 0 && pos >= 0) {
#pragma unroll
            for (int j = 0; j < 8; ++j) { const float2 cs = ROPE[pos * 8 + j]; const float a = x[j], c = x[8 + j]; x[j] = a * cs.x - c * cs.y; x[8 + j] = c * cs.x + a * cs.y; } }
#pragma unroll
        for (int j = 0; j < 4; ++j) { u32x4 o; o.x = pk2(x[8 * j], x[8 * j + 1]); o.y = pk2(x[8 * j + 2], x[8 * j + 3]); o.z = pk2(x[8 * j + 4], x[8 * j + 5]); o.w = pk2(x[8 * j + 6], x[8 * j + 7]);
            *(LAS u32x4*)(L + SW_KS + key * 144 + (32 * half + 8 * j) * 2) = o; }
    }
    {
        const int kp = tid >> 2, dq = tid & 3; const int pos0 = (qb - 1) * 128 + 2 * kp;
        u32x4 a0 = {0u, 0u, 0u, 0u}, a1 = a0, c0 = a0, c1 = a0;
        if (pos0 >= 0) { const u32x4* s0 = (const u32x4*)(SV + ((size_t)b * SEQ + pos0) * 256 + kvh * 64 + 16 * dq); const u32x4* s1 = (const u32x4*)(SV + ((size_t)b * SEQ + pos0 + 1) * 256 + kvh * 64 + 16 * dq);
            a0 = s0[0]; a1 = s0[1]; c0 = s1[0]; c1 = s1[1]; }
        const unsigned va[8] = {a0.x, a0.y, a0.z, a0.w, a1.x, a1.y, a1.z, a1.w}, vb[8] = {c0.x, c0.y, c0.z, c0.w, c1.x, c1.y, c1.z, c1.w};
#pragma unroll
        for (int j = 0; j < 16; ++j) { const unsigned a = va[j >> 1], c = vb[j >> 1];
            const unsigned pk = (j & 1) ? ((a >> 16) | (c & 0xffff0000u)) : ((a & 0xffffu) | (c << 16));
            *(LAS unsigned*)(L + SW_VT + (16 * dq + j) * 528 + kp * 4) = pk; }
    }
    for (int gh = 0; gh < 4; ++gh) {
        const int h = kvh * 4 + gh;
        if (gh > 0) __syncthreads();
        {
            const int row = tid >> 2, qq = tid & 3; const int pos = qb * 128 + row;
            const u32x4* src = (const u32x4*)(SQ + ((size_t)b * SEQ + pos) * 1024 + h * 64 + 16 * qq);
            float x[16];
#pragma unroll
            for (int j = 0; j < 2; ++j) { const u32x4 v = src[j]; x[8 * j + 0] = bf_lo(v.x); x[8 * j + 1] = bf_hi(v.x); x[8 * j + 2] = bf_lo(v.y); x[8 * j + 3] = bf_hi(v.y); x[8 * j + 4] = bf_lo(v.z); x[8 * j + 5] = bf_hi(v.z); x[8 * j + 6] = bf_lo(v.w); x[8 * j + 7] = bf_hi(v.w); }
            float ss = 0.f;
#pragma unroll
            for (int j = 0; j < 16; ++j) ss += x[j] * x[j];
            ss += __shfl_xor(ss, 1); ss += __shfl_xor(ss, 2);
            const float rstd = 1.f / sqrtf(ss * (1.f / 64.f) + EPS);
#pragma unroll
            for (int j = 0; j < 16; ++j) x[j] = x[j] * rstd * qng[16 * qq + j];
            if (qq == 0) {
#pragma unroll
                for (int j = 0; j < 8; ++j) { const float2 cs = ROPE[pos * 8 + j]; const float a = x[j], c = x[8 + j]; x[j] = a * cs.x - c * cs.y; x[8 + j] = c * cs.x + a * cs.y; } }
#pragma unroll
            for (int j = 0; j < 2; ++j) { u32x4 o; o.x = pk2(0.125f * x[8 * j], 0.125f * x[8 * j + 1]); o.y = pk2(0.125f * x[8 * j + 2], 0.125f * x[8 * j + 3]); o.z = pk2(0.125f * x[8 * j + 4], 0.125f * x[8 * j + 5]); o.w = pk2(0.125f * x[8 * j + 6], 0.125f * x[8 * j + 7]);
                *(LAS u32x4*)(L + SW_QS + row * 144 + (16 * qq + 8 * j) * 2) = o; }
        }
        __syncthreads();
        const int kt0 = w < 6 ? w : 6;
        const int qi = 16 * w + l16;
        bf16x8 qf[2];
#pragma unroll
        for (int ks = 0; ks < 2; ++ks) qf[ks] = *(const LAS bf16x8*)(L + SW_QS + qi * 144 + (32 * ks + 8 * g4) * 2);
        const float sink = sinks[h];
        float sc[10][4]; float mx = sink;
#pragma unroll
        for (int t = 0; t < 10; ++t) { const int kt = kt0 + t; f32x4 a4 = {0.f, 0.f, 0.f, 0.f};
#pragma unroll
            for (int ks = 0; ks < 2; ++ks) { const bf16x8 A = *(const LAS bf16x8*)(L + SW_KS + (16 * kt + l16) * 144 + (32 * ks + 8 * g4) * 2);
                a4 = __builtin_amdgcn_mfma_f32_16x16x32_bf16(A, qf[ks], a4, 0, 0, 0); }
#pragma unroll
            for (int i = 0; i < 4; ++i) { const int kp = 16 * kt + 4 * g4 + i; const bool valid = (kp > qi) && (kp <= qi + 128) && (qb > 0 || kp >= 128);
                sc[t][i] = valid ? a4[i] : -1e30f; mx = fmaxf(mx, sc[t][i]); } }
        mx = fmaxf(mx, __shfl_xor(mx, 16)); mx = fmaxf(mx, __shfl_xor(mx, 32));
        float sum = 0.f;
#pragma unroll
        for (int t = 0; t < 10; ++t)
#pragma unroll
            for (int i = 0; i < 4; ++i) { const float p = (sc[t][i] > -1e29f) ? __expf(sc[t][i] - mx) : 0.f; sc[t][i] = p; sum += p; }
        sum += __shfl_xor(sum, 16); sum += __shfl_xor(sum, 32);
        const float inv = 1.f / (sum + __expf(sink - mx));
        f32x4 o4[4];
#pragma unroll
        for (int dt = 0; dt < 4; ++dt) o4[dt] = (f32x4){0.f, 0.f, 0.f, 0.f};
#pragma unroll
        for (int pp = 0; pp < 5; ++pp) { const int ta = 2 * pp, tb = 2 * pp + 1;
            u32x4 pa; pa.x = pk2(sc[ta][0] * inv, sc[ta][1] * inv); pa.y = pk2(sc[ta][2] * inv, sc[ta][3] * inv); pa.z = pk2(sc[tb][0] * inv, sc[tb][1] * inv); pa.w = pk2(sc[tb][2] * inv, sc[tb][3] * inv);
            const bf16x8 A = __builtin_bit_cast(bf16x8, pa);
#pragma unroll
            for (int dt = 0; dt < 4; ++dt) { const int d = 16 * dt + l16;
                const u64 lo = *(const LAS u64*)(L + SW_VT + d * 528 + (16 * (kt0 + ta) + 4 * g4) * 2), hi = *(const LAS u64*)(L + SW_VT + d * 528 + (16 * (kt0 + tb) + 4 * g4) * 2);
                o4[dt] = __builtin_amdgcn_mfma_f32_16x16x32_bf16(A, mk8(lo, hi), o4[dt], 0, 0, 0); } }
#pragma unroll
        for (int dt = 0; dt < 4; ++dt)
#pragma unroll
            for (int i = 0; i < 4; ++i) OB[((size_t)b * SEQ + qb * 128 + 16 * w + 4 * g4 + i) * 1024 + h * 64 + 16 * dt + l16] = (bf16)f2bf(o4[dt][i]);
    }
}
constexpr int PK_SK = 0, PK_S12 = 2 * 128 * 272;
static_assert(PK_S12 + 32 * 512 * 4 <= MISC_OFF, "peer lds");
template <class K> __device__ __forceinline__ K kmax_(K a, K b);
template <class K> __device__ __forceinline__ K kmin_(K a, K b);
template <> __device__ __forceinline__ float kmax_<float>(float a, float b) { return fmaxf(a, b); }
template <> __device__ __forceinline__ float kmin_<float>(float a, float b) { return fminf(a, b); }
struct K2 { unsigned h, l; };
template <> __device__ __forceinline__ K2 kmax_<K2>(K2 a, K2 b) { const bool gt = a.h > b.h; K2 r; r.h = gt ? a.h : b.h; r.l = gt ? a.l : b.l; return r; }
template <> __device__ __forceinline__ K2 kmin_<K2>(K2 a, K2 b) { const bool gt = a.h > b.h; K2 r; r.h = gt ? b.h : a.h; r.l = gt ? b.l : a.l; return r; }
template <class K> __device__ __forceinline__ void ce_(K& a, K& b, bool desc) { const K hi = kmax_<K>(a, b), lo = kmin_<K>(a, b); a = desc ? hi : lo; b = desc ? lo : hi; }
template <class K> __device__ __forceinline__ void sort16_desc(K* v) {
#pragma unroll
    for (int k = 2; k <= 16; k <<= 1)
#pragma unroll
        for (int j = k >> 1; j > 0; j >>= 1)
#pragma unroll
            for (int i = 0; i < 16; ++i) { const int l = i ^ j; if (l > i) ce_<K>(v[i], v[l], (i & k) == 0); }
}
template <class K> __device__ __forceinline__ void bmerge16_desc(K* v) {
#pragma unroll
    for (int j = 8; j > 0; j >>= 1)
#pragma unroll
        for (int i = 0; i < 16; ++i) { const int l = i ^ j; if (l > i) ce_<K>(v[i], v[l], true); }
}
template <class K> __device__ __forceinline__ void merge_top16(K* a, const K* b) {
#pragma unroll
    for (int i = 0; i < 16; ++i) a[i] = kmax_<K>(a[i], b[15 - i]);
    bmerge16_desc<K>(a);
}
template <class K> __device__ __forceinline__ void top16_of_64(K* v) {
    sort16_desc<K>(v); sort16_desc<K>(v + 16); sort16_desc<K>(v + 32); sort16_desc<K>(v + 48);
    merge_top16<K>(v, v + 16); merge_top16<K>(v + 32, v + 48); merge_top16<K>(v, v + 32);
}
__device__ __forceinline__ unsigned ford(float f) { const unsigned u = __builtin_bit_cast(unsigned, f); return (u & 0x80000000u) ? ~u : (u | 0x80000000u); }
__device__ __forceinline__ float funord(unsigned k) { const unsigned u = (k & 0x80000000u) ? (k & 0x7fffffffu) : ~k; return __builtin_bit_cast(float, u); }

__device__ const unsigned char STAIR[64] = {0, 1, 2, 3, 4, 5, 6, 7, 8, 9, 10, 11, 12, 13, 14, 15, 16, 17, 18, 19, 20, 21, 22, 23, 32, 33, 34, 35, 36, 48, 49, 50, 51, 64, 65, 66, 80, 81, 96, 97, 112, 113, 128, 144, 160, 176, 192, 208, 224, 240, 0, 0, 0, 0, 0, 0, 0, 0, 0, 0, 0, 0, 0, 0};
__device__ __forceinline__ void peer_topk_unit(Frame& F, int tile, int hh) {
    using pg8::bf16x8; using pg8::u32x4;
    const ldsp L = F.lds; const int tid = F.tid, lane = F.lane, w = F.wave, hb = lane >> 5, l32 = lane & 31;
    const bf16* QP = (const bf16*)(F.ws + WS_QP); const bf16* SUBK = (const bf16*)(F.ws + WS_SUBK);
    int* IDX = (int*)(F.ws + WS_IDX); float* GATE = (float*)(F.ws + WS_GATE);
    __syncthreads();
    {
        const u32x4* src = (const u32x4*)(SUBK + (size_t)hh * 2 * 128 * 128);
#pragma unroll
        for (int r = 0; r < 8; ++r) { const int idx = tid + r * NTHR; const int row = idx >> 4, c = idx & 15;
            *(LAS u32x4*)(L + PK_SK + row * 272 + c * 16) = src[idx]; }
    }
    __syncthreads();
    const int tok = tile * 256 + 32 * w + l32;
    LAS float* S12 = (LAS float*)(L + PK_S12) + tid;
#pragma unroll 1
    for (int p = 0; p < 2; ++p) {
        bf16x8 Bq[8];
        const u32x4* qsrc = (const u32x4*)(QP + (size_t)tok * 2048 + (2 * hh + p) * 128);
#pragma unroll
        for (int ks = 0; ks < 8; ++ks) Bq[ks] = __builtin_bit_cast(bf16x8, qsrc[2 * ks + hb]);
        float v[16];
#pragma unroll
        for (int kt = 0; kt < 4; ++kt) { f32x16 acc;
#pragma unroll
            for (int i = 0; i < 16; ++i) acc[i] = 0.f;
#pragma unroll
            for (int ks = 0; ks < 8; ++ks) { const bf16x8 A = *(const LAS bf16x8*)(L + PK_SK + (p * 128 + 32 * kt + l32) * 272 + (16 * ks + 8 * hb) * 2);
                acc = __builtin_amdgcn_mfma_f32_32x32x16_bf16(A, Bq[ks], acc, 0, 0, 0); }
            float cur[16];
#pragma unroll
            for (int i = 0; i < 16; ++i) { const int key = 32 * kt + 8 * (i >> 2) + 4 * hb + (i & 3);
                const float sci = acc[i];
                cur[i] = __builtin_bit_cast(float, (__builtin_bit_cast(unsigned, sci) & ~127u) | (unsigned)(127 - key)); }
            sort16_desc<float>(cur);
            if (kt == 0) {
#pragma unroll
                for (int i = 0; i < 16; ++i) v[i] = cur[i]; }
            else merge_top16<float>(v, cur);
            __builtin_amdgcn_sched_barrier(0); }
        float o[16];
#pragma unroll
        for (int i = 0; i < 16; ++i) o[i] = __shfl_xor(v[15 - i], 32);
#pragma unroll
        for (int i = 0; i < 16; ++i) v[i] = fmaxf(v[i], o[i]);
        bmerge16_desc<float>(v);
#pragma unroll
        for (int i = 0; i < 16; ++i) S12[(p * 16 + i) * NTHR] = v[i];
    }
    float s12[2][16];
#pragma unroll
    for (int p = 0; p < 2; ++p)
#pragma unroll
        for (int i = 0; i < 16; ++i) s12[p][i] = S12[(p * 16 + i) * NTHR];
    float c[16];
#pragma unroll
    for (int gq = 0; gq < 4; ++gq) {
        float cur[16];
#pragma unroll
        for (int q = 0; q < 16; ++q) cur[q] = -3.0e38f;
        int n = 0;
#pragma unroll
        for (int i = 0; i < 16; ++i)
#pragma unroll
            for (int j = 0; j < 16; ++j) if ((i + 1) * (j + 1) <= 16) {
                if ((n >> 4) == gq) {
                    const unsigned b1 = __builtin_bit_cast(unsigned, s12[0][i]), b2 = __builtin_bit_cast(unsigned, s12[1][j]);
                    const float sum = __builtin_bit_cast(float, b1 & ~127u) + __builtin_bit_cast(float, b2 & ~127u);
                    cur[n & 15] = __builtin_bit_cast(float, (__builtin_bit_cast(unsigned, sum) & ~63u) | (unsigned)n); }
                ++n; }
        sort16_desc<float>(cur);
        if (gq == 0) {
#pragma unroll
            for (int q = 0; q < 16; ++q) c[q] = cur[q]; }
        else merge_top16<float>(c, cur);
        __builtin_amdgcn_sched_barrier(0);
    }
    float best[16]; int eidx[16]; float m = -3.0e38f;
#pragma unroll
    for (int k = 0; k < 16; ++k) { const unsigned cid = __builtin_bit_cast(unsigned, c[k]) & 63u; const unsigned ij = STAIR[cid];
        const unsigned b1 = __builtin_bit_cast(unsigned, S12[(ij >> 4) * NTHR]), b2 = __builtin_bit_cast(unsigned, S12[(16 + (ij & 15u)) * NTHR]);
        best[k] = __builtin_bit_cast(float, b1 & ~127u) + __builtin_bit_cast(float, b2 & ~127u); m = fmaxf(m, best[k]);
        eidx[k] = (int)(((127u - (b1 & 127u)) << 7) | (127u - (b2 & 127u))); }
    float sum = 0.f;
#pragma unroll
    for (int k = 0; k < 16; ++k) { best[k] = __expf(best[k] - m); sum += best[k]; }
    const float inv = 1.f / sum;
    if (hb == 0) { int4* dst = (int4*)(IDX + (size_t)tok * 128 + hh * 16);
#pragma unroll
        for (int k4 = 0; k4 < 4; ++k4) dst[k4] = make_int4(eidx[4 * k4], eidx[4 * k4 + 1], eidx[4 * k4 + 2], eidx[4 * k4 + 3]); }
    else { float4* dst = (float4*)(GATE + (size_t)tok * 128 + hh * 16);
#pragma unroll
        for (int k4 = 0; k4 < 4; ++k4) dst[k4] = make_float4(best[4 * k4] * inv, best[4 * k4 + 1] * inv, best[4 * k4 + 2] * inv, best[4 * k4 + 3] * inv); }
}


__device__ __forceinline__ void wave_argmax(float& v, int& p) {
#pragma unroll
    for (int o = 1; o < 64; o <<= 1) { const float ov = __shfl_xor(v, o); const int op = __shfl_xor(p, o); const bool t = (ov > v) || (ov == v && op < p); v = t ? ov : v; p = t ? op : p; }
}
__device__ __forceinline__ void peer_topk_slow(Frame& F, int tok, int hh) {
    using pg8::u32x4;
    const int lane = F.lane;
    const bf16* QP = (const bf16*)(F.ws + WS_QP) + (size_t)tok * 2048 + hh * 256; const bf16* SUBK = (const bf16*)(F.ws + WS_SUBK) + (size_t)hh * 2 * 128 * 128;
    float sv[2] = {0.f, 0.f}; int sk[2] = {0, 0};
#pragma unroll 1
    for (int p = 0; p < 2; ++p) {
        float sc0 = 0.f, sc1 = 0.f;
        const u32x4* q4 = (const u32x4*)(QP + p * 128); const u32x4* k0 = (const u32x4*)(SUBK + ((size_t)p * 128 + lane) * 128); const u32x4* k1 = (const u32x4*)(SUBK + ((size_t)p * 128 + lane + 64) * 128);
#pragma unroll 4
        for (int c = 0; c < 16; ++c) { const u32x4 q = q4[c], a = k0[c], b = k1[c];
            sc0 += bf_lo(q.x) * bf_lo(a.x) + bf_hi(q.x) * bf_hi(a.x) + bf_lo(q.y) * bf_lo(a.y) + bf_hi(q.y) * bf_hi(a.y) + bf_lo(q.z) * bf_lo(a.z) + bf_hi(q.z) * bf_hi(a.z) + bf_lo(q.w) * bf_lo(a.w) + bf_hi(q.w) * bf_hi(a.w);
            sc1 += bf_lo(q.x) * bf_lo(b.x) + bf_hi(q.x) * bf_hi(b.x) + bf_lo(q.y) * bf_lo(b.y) + bf_hi(q.y) * bf_hi(b.y) + bf_lo(q.z) * bf_lo(b.z) + bf_hi(q.z) * bf_hi(b.z) + bf_lo(q.w) * bf_lo(b.w) + bf_hi(q.w) * bf_hi(b.w); }
        float wv = 0.f; int wk = 0;
#pragma unroll 1
        for (int it = 0; it < 16; ++it) { float v = sc0 >= sc1 ? sc0 : sc1; int key = sc0 >= sc1 ? lane : lane + 64;
            wave_argmax(v, key);
            if (key == lane) sc0 = -3.0e38f; if (key == lane + 64) sc1 = -3.0e38f;
            if (lane == it) { wv = v; wk = key; } }
        if (p == 0) { sv[0] = wv; sk[0] = wk; } else { sv[1] = wv; sk[1] = wk; }
    }
    float cv[4]; int cp[4];
#pragma unroll
    for (int r = 0; r < 4; ++r) { const int c = lane + 64 * r, i = c >> 4, j = c & 15; cv[r] = __shfl(sv[0], i) + __shfl(sv[1], j); cp[r] = c; }
    float bv = 0.f; int bp = 0;
#pragma unroll 1
    for (int it = 0; it < 16; ++it) { float v = cv[0]; int c = cp[0];
#pragma unroll
        for (int r = 1; r < 4; ++r) if (cv[r] > v) { v = cv[r]; c = cp[r]; }
        wave_argmax(v, c);
#pragma unroll
        for (int r = 0; r < 4; ++r) if (cp[r] == c) cv[r] = -3.0e38f;
        if (lane == it) { bv = v; bp = c; } }
    const int k1 = __shfl(sk[0], bp >> 4), k2 = __shfl(sk[1], bp & 15);
    float m = bv;
#pragma unroll
    for (int o = 1; o < 16; o <<= 1) m = fmaxf(m, __shfl_xor(m, o));
    const float e = __expf(bv - m); float sum = e;
#pragma unroll
    for (int o = 1; o < 16; o <<= 1) sum += __shfl_xor(sum, o);
    if (lane < 16) { ((int*)(F.ws + WS_IDX))[(size_t)tok * 128 + hh * 16 + lane] = k1 * 128 + k2; ((float*)(F.ws + WS_GATE))[(size_t)tok * 128 + hh * 16 + lane] = e / sum; }
}
__device__ __forceinline__ float gelu_erf(float x) { return 0.5f * x * (1.f + erff(x * 0.70710678118654752f)); }
constexpr size_t WS_SCLU = WS_ROPE + 256 * 1024, WS_SCLV = WS_ROPE + 384 * 1024;
constexpr size_t PEER_SLICE = (size_t)16384 * 128;
constexpr size_t WS_PU = 384 * MiB;
typedef float f32x2_t __attribute__((ext_vector_type(2)));
__device__ __forceinline__ void row_to_fp8(int lane, const float* src, unsigned char* dst, float* inv_scale) {
    using pg8::f32x4; using pg8::u32x4;
    const f32x4* s4 = (const f32x4*)src + 4 * lane;
    f32x4 v[4]; float am = 0.f;
#pragma unroll
    for (int j = 0; j < 4; ++j) { v[j] = s4[j]; am = fmaxf(am, fmaxf(fmaxf(fabsf(v[j].x), fabsf(v[j].y)), fmaxf(fabsf(v[j].z), fabsf(v[j].w)))); }
#pragma unroll
    for (int o = 1; o < 64; o <<= 1) am = fmaxf(am, __shfl_xor(am, o));
    float sc = 1.f;
    if (am > 0.f) { int e; (void)frexpf(448.f / am, &e); sc = ldexpf(1.f, e - 1); }
    int p[4];
#pragma unroll
    for (int j = 0; j < 4; ++j) { p[j] = __builtin_amdgcn_cvt_pk_fp8_f32(v[j].x * sc, v[j].y * sc, 0, false); p[j] = __builtin_amdgcn_cvt_pk_fp8_f32(v[j].z * sc, v[j].w * sc, p[j], true); }
    u32x4 o; o.x = (unsigned)p[0]; o.y = (unsigned)p[1]; o.z = (unsigned)p[2]; o.w = (unsigned)p[3];
    *(u32x4*)(dst + (size_t)(lane >> 3) * PEER_SLICE + 16 * (lane & 7)) = o;
    if (lane == 0) *inv_scale = 1.f / sc;
}
struct PeerPre { int rows[16]; pg8::u32x4 x0, x1; };
__device__ __forceinline__ void peer_u_load(Frame& F, int tok, int vs, PeerPre& p) {
    const int lane = F.lane, rsub = lane >> 3, c = lane & 7;
    const bf16* XN = (const bf16*)(F.ws + WS_XN2) + (size_t)tok * D + vs * 128; const int* IDX = (const int*)(F.ws + WS_IDX) + (size_t)tok * 128;
#pragma unroll
    for (int g = 0; g < 16; ++g) p.rows[g] = IDX[(unsigned)(rsub + 8 * g)];
    p.x0 = *(const pg8::u32x4*)(XN + (unsigned)(16 * c)); p.x1 = *(const pg8::u32x4*)(XN + (unsigned)(16 * c + 8));
}
__device__ __forceinline__ void peer_dot8(const pg8::u32x4* ua, const float* xf, float* part) {
    f32x2_t x2[8];
#pragma unroll
    for (int q = 0; q < 8; ++q) x2[q] = (f32x2_t){xf[2 * q], xf[2 * q + 1]};
#pragma unroll
    for (int g = 0; g < 8; ++g) { const unsigned uw[4] = {ua[g].x, ua[g].y, ua[g].z, ua[g].w}; f32x2_t sa = {0.f, 0.f}, sb = {0.f, 0.f};
#pragma unroll
        for (int q = 0; q < 4; ++q) { const f32x2_t a = __builtin_amdgcn_cvt_pk_f32_fp8((int)uw[q], false), b2 = __builtin_amdgcn_cvt_pk_f32_fp8((int)uw[q], true);
            sa = __builtin_elementwise_fma(a, x2[2 * q], sa); sb = __builtin_elementwise_fma(b2, x2[2 * q + 1], sb); }
        const f32x2_t st = sa + sb; part[g] = st.x + st.y; }
}
__device__ __forceinline__ void peer_u_slice(Frame& F, int vs, int tok0, int tstep) {
    using pg8::u32x4;
    const int lane = F.lane, rsub = lane >> 3, c = lane & 7;
    const unsigned char* U8 = F.ws + WS_U + (size_t)vs * PEER_SLICE; const unsigned co = 16u * (unsigned)c;
    if (tok0 >= T) return;
    PeerPre cur, nxt; peer_u_load(F, tok0, vs, cur); nxt = cur;
    float pprev[16]; int tokp = -1;
#pragma unroll
    for (int k = 0; k < 16; ++k) pprev[k] = 0.f;
    u32x4 bufA[8], bufB[8];
#pragma unroll
    for (int g = 0; g < 8; ++g) bufA[g] = *(const u32x4*)(U8 + ((unsigned)cur.rows[g] * 128u + co));
#pragma unroll 1
    for (int tok = tok0; tok < T; tok += tstep) {
        const int tokn = tok + tstep;
#pragma unroll
        for (int g = 0; g < 8; ++g) bufB[g] = *(const u32x4*)(U8 + ((unsigned)cur.rows[8 + g] * 128u + co));
        if (tokn < T) peer_u_load(F, tokn, vs, nxt);
        const unsigned xw[8] = {cur.x0.x, cur.x0.y, cur.x0.z, cur.x0.w, cur.x1.x, cur.x1.y, cur.x1.z, cur.x1.w};
        float xf[16];
#pragma unroll
        for (int q = 0; q < 8; ++q) { xf[2 * q] = bf_lo(xw[q]); xf[2 * q + 1] = bf_hi(xw[q]); }
        float part[16];
        {
            const bool h2 = (lane & 4) != 0, h1 = (lane & 2) != 0, h0 = (lane & 1) != 0;
            float a8[8], b4[4], c2v[2];
#pragma unroll
            for (int k = 0; k < 8; ++k) { const float keep = h2 ? pprev[k + 8] : pprev[k], send = h2 ? pprev[k] : pprev[k + 8]; a8[k] = keep + __shfl_xor(send, 4); }
#pragma unroll
            for (int k = 0; k < 4; ++k) { const float keep = h1 ? a8[k + 4] : a8[k], send = h1 ? a8[k] : a8[k + 4]; b4[k] = keep + xchg2(send); }
#pragma unroll
            for (int k = 0; k < 2; ++k) { const float keep = h0 ? b4[k + 2] : b4[k], send = h0 ? b4[k] : b4[k + 2]; c2v[k] = keep + xchg1(send); }
            const int g0 = 8 * (h2 ? 1 : 0) + 4 * (h1 ? 1 : 0) + 2 * (h0 ? 1 : 0);
            if (tokp >= 0) { float* PU = (float*)(F.ws + WS_PU) + ((size_t)tokp * 8 + vs) * 128; PU[8 * g0 + rsub] = c2v[0]; PU[8 * (g0 + 1) + rsub] = c2v[1]; }
        }
        peer_dot8(bufA, xf, part);
        __builtin_amdgcn_sched_barrier(0);
        if (tokn < T) {
#pragma unroll
            for (int g = 0; g < 8; ++g) bufA[g] = *(const u32x4*)(U8 + ((unsigned)nxt.rows[g] * 128u + co)); }
        peer_dot8(bufB, xf, part + 8);
        __builtin_amdgcn_sched_barrier(0);
#pragma unroll
        for (int k = 0; k < 16; ++k) pprev[k] = part[k];
        tokp = tok;
        cur = nxt;
    }
    {
        const bool h2 = (lane & 4) != 0, h1 = (lane & 2) != 0, h0 = (lane & 1) != 0;
        float a8[8], b4[4], c2v[2];
#pragma unroll
        for (int k = 0; k < 8; ++k) { const float keep = h2 ? pprev[k + 8] : pprev[k], send = h2 ? pprev[k] : pprev[k + 8]; a8[k] = keep + __shfl_xor(send, 4); }
#pragma unroll
        for (int k = 0; k < 4; ++k) { const float keep = h1 ? a8[k + 4] : a8[k], send = h1 ? a8[k] : a8[k + 4]; b4[k] = keep + xchg2(send); }
#pragma unroll
        for (int k = 0; k < 2; ++k) { const float keep = h0 ? b4[k + 2] : b4[k], send = h0 ? b4[k] : b4[k + 2]; c2v[k] = keep + xchg1(send); }
        const int g0 = 8 * (h2 ? 1 : 0) + 4 * (h1 ? 1 : 0) + 2 * (h0 ? 1 : 0);
        if (tokp >= 0) { float* PU = (float*)(F.ws + WS_PU) + ((size_t)tokp * 8 + vs) * 128; PU[8 * g0 + rsub] = c2v[0]; PU[8 * (g0 + 1) + rsub] = c2v[1]; }
    }
}
__device__ __forceinline__ void peer_w_token2(Frame& F, int tokA, int tokB) {
    const int lane = F.lane;
    const float* SCLU = (const float*)(F.ws + WS_SCLU); const float* SCLV = (const float*)(F.ws + WS_SCLV);
    float pu[2][2][8]; int row[2][2]; float gt[2][2];
#pragma unroll
    for (int t = 0; t < 2; ++t) { const int tok = t ? tokB : tokA;
        const float* PU = (const float*)(F.ws + WS_PU) + (size_t)tok * 8 * 128; const int* IDX = (const int*)(F.ws + WS_IDX) + (size_t)tok * 128; const float* GATE = (const float*)(F.ws + WS_GATE) + (size_t)tok * 128;
#pragma unroll
        for (int q = 0; q < 2; ++q) { const int e = lane + 64 * q;
#pragma unroll
            for (int v = 0; v < 8; ++v) pu[t][q][v] = PU[v * 128 + e];
            row[t][q] = IDX[e]; gt[t][q] = GATE[e]; } }
#pragma unroll
    for (int t = 0; t < 2; ++t) { const int tok = t ? tokB : tokA; if (t == 1 && tokB == tokA) break;
        unsigned* REC = (unsigned*)(F.ws + WS_GATE) + (size_t)tok * 128;
#pragma unroll
        for (int q = 0; q < 2; ++q) { const int e = lane + 64 * q; float sacc = 0.f;
#pragma unroll
            for (int v = 0; v < 8; ++v) sacc += pu[t][q][v];
            const float wv_ = gelu_erf(sacc * SCLU[row[t][q]]) * gt[t][q] * SCLV[row[t][q]];
            REC[e] = ((unsigned)row[t][q] << 16) | f2bf(wv_); } }
}
struct PeerPreV { unsigned rec[16]; };
__device__ __forceinline__ void peer_v_load(Frame& F, int tok, PeerPreV& p) {
    const int rsub = F.lane >> 3;
    const unsigned* REC = (const unsigned*)(F.ws + WS_GATE) + (size_t)tok * 128;
#pragma unroll
    for (int g = 0; g < 16; ++g) p.rec[g] = REC[(unsigned)(rsub + 8 * g)];
}
__device__ __forceinline__ void peer_axpy8(const pg8::u32x4* va, const unsigned* rec, f32x2_t* acc2) {
#pragma unroll
    for (int g = 0; g < 8; ++g) { const unsigned vw[4] = {va[g].x, va[g].y, va[g].z, va[g].w}; const float wg_ = __builtin_bit_cast(float, rec[g] << 16); const f32x2_t w2 = {wg_, wg_};
#pragma unroll
        for (int q = 0; q < 4; ++q) { const f32x2_t a = __builtin_amdgcn_cvt_pk_f32_fp8((int)vw[q], false), b2 = __builtin_amdgcn_cvt_pk_f32_fp8((int)vw[q], true);
            acc2[2 * q] = __builtin_elementwise_fma(w2, a, acc2[2 * q]); acc2[2 * q + 1] = __builtin_elementwise_fma(w2, b2, acc2[2 * q + 1]); } }
}
__device__ __forceinline__ void peer_v_slice(Frame& F, int vs, int tok0, int tstep) {
    using pg8::u32x4;
    const int lane = F.lane, c = lane & 7;
    const unsigned char* V8 = F.ws + WS_V + (size_t)vs * PEER_SLICE; const unsigned co = 16u * (unsigned)c;
    if (tok0 >= T) return;
    PeerPreV cur, nxt; peer_v_load(F, tok0, cur); nxt = cur;
    float aprev[16]; int tokp = -1;
#pragma unroll
    for (int k = 0; k < 16; ++k) aprev[k] = 0.f;
    u32x4 bufA[8], bufB[8];
#pragma unroll
    for (int g = 0; g < 8; ++g) bufA[g] = *(const u32x4*)(V8 + ((cur.rec[g] >> 16) * 128u + co));
#pragma unroll 1
    for (int tok = tok0; tok < T; tok += tstep) {
        const int tokn = tok + tstep;
#pragma unroll
        for (int g = 0; g < 8; ++g) bufB[g] = *(const u32x4*)(V8 + ((cur.rec[8 + g] >> 16) * 128u + co));
        if (tokn < T) peer_v_load(F, tokn, nxt);
        f32x2_t acc2[8];
#pragma unroll
        for (int j = 0; j < 8; ++j) acc2[j] = (f32x2_t){0.f, 0.f};
        {
            const bool h5 = (lane & 32) != 0, h4 = (lane & 16) != 0, h3 = (lane & 8) != 0;
            float a8[8], b4[4], c2v[2];
#pragma unroll
            for (int k = 0; k < 8; ++k) { const float keep = h5 ? aprev[k + 8] : aprev[k], send = h5 ? aprev[k] : aprev[k + 8]; a8[k] = keep + __shfl_xor(send, 32); }
#pragma unroll
            for (int k = 0; k < 4; ++k) { const float keep = h4 ? a8[k + 4] : a8[k], send = h4 ? a8[k] : a8[k + 4]; b4[k] = keep + __shfl_xor(send, 16); }
#pragma unroll
            for (int k = 0; k < 2; ++k) { const float keep = h3 ? b4[k + 2] : b4[k], send = h3 ? b4[k] : b4[k + 2]; c2v[k] = keep + __shfl_xor(send, 8); }
            const int j0 = 8 * (h5 ? 1 : 0) + 4 * (h4 ? 1 : 0) + 2 * (h3 ? 1 : 0);
            if (tokp >= 0) { float2* op = (float2*)(F.out + (size_t)tokp * D + vs * 128 + 16 * c + j0); float2 r = *op; r.x += c2v[0]; r.y += c2v[1]; *op = r; }
        }
        peer_axpy8(bufA, cur.rec, acc2);
        __builtin_amdgcn_sched_barrier(0);
        if (tokn < T) {
#pragma unroll
            for (int g = 0; g < 8; ++g) bufA[g] = *(const u32x4*)(V8 + ((nxt.rec[g] >> 16) * 128u + co)); }
        peer_axpy8(bufB, cur.rec + 8, acc2);
        __builtin_amdgcn_sched_barrier(0);
#pragma unroll
        for (int j = 0; j < 8; ++j) { aprev[2 * j] = acc2[j].x; aprev[2 * j + 1] = acc2[j].y; }
        tokp = tok;
        cur = nxt;
    }
    {
            const bool h5 = (lane & 32) != 0, h4 = (lane & 16) != 0, h3 = (lane & 8) != 0;
            float a8[8], b4[4], c2v[2];
#pragma unroll
            for (int k = 0; k < 8; ++k) { const float keep = h5 ? aprev[k + 8] : aprev[k], send = h5 ? aprev[k] : aprev[k + 8]; a8[k] = keep + __shfl_xor(send, 32); }
#pragma unroll
            for (int k = 0; k < 4; ++k) { const float keep = h4 ? a8[k + 4] : a8[k], send = h4 ? a8[k] : a8[k + 4]; b4[k] = keep + __shfl_xor(send, 16); }
#pragma unroll
            for (int k = 0; k < 2; ++k) { const float keep = h3 ? b4[k + 2] : b4[k], send = h3 ? b4[k] : b4[k + 2]; c2v[k] = keep + __shfl_xor(send, 8); }
            const int j0 = 8 * (h5 ? 1 : 0) + 4 * (h4 ? 1 : 0) + 2 * (h3 ? 1 : 0);
            if (tokp >= 0) { float2* op = (float2*)(F.out + (size_t)tokp * D + vs * 128 + 16 * c + j0); float2 r = *op; r.x += c2v[0]; r.y += c2v[1]; *op = r; }
    }
}

struct Args { const float* in[17]; float* out; unsigned char* ws; int ph_lo, ph_hi; };
constexpr int N_PHASES = 13;
__global__ void __launch_bounds__(NTHR, 2) mega_fwd(Args args) {
    extern __shared__ __attribute__((aligned(16))) unsigned char lds[];
    Frame F;
    F.lds = (ldsp)lds; F.ws = args.ws; F.out = args.out;
#pragma unroll
    for (int i = 0; i < 17; ++i) F.in[i] = args.in[i];
    F.tid = threadIdx.x; F.lane = F.tid & 63; F.wave = __builtin_amdgcn_readfirstlane(F.tid >> 6);
    F.G = gridDim.x; { const int bx = blockIdx.x; F.vcu = (F.G % 8 == 0) ? (bx % 8) * (F.G / 8) + bx / 8 : bx; }
    volatile LAS unsigned* MISC = (volatile LAS unsigned*)(F.lds + MISC_OFF);
    if (F.tid < 64) MISC[F.tid] = 0u;
    __syncthreads();
    XcdBarrier bar = xcd_barrier_post((unsigned*)(args.ws + WS_CTL) + CW_BAR, MISC + 8);
    const int lo = args.ph_lo, hi = args.ph_hi;
#define IN(k) (lo <= (k) && (k) < hi)
#define SEAM(k) do { if (IN(k) && IN((k) + 1)) xcd_barrier(bar); } while (0)

    if (IN(0)) { p0_prologue(F); } SEAM(0);
    if (IN(1)) {
        pg8::Gemm g{(const pg8::bf16_t*)(F.ws + WS_H), (const pg8::bf16_t*)(F.ws + WS_WIN), T, NPROJ, D}; pg8::StaticOrder S; S.init(T, NPROJ, F.G, (int)blockIdx.x);
        EpiB<0> E{F.ws}; pg8::gemm_phase<EpiB<0>, pg8::StaticOrder, true, true>(F.lds, g, S, E);
    } SEAM(1);
    if (IN(2)) {
        PreRegs cur, nxt; cur.gl = (pg8::f32x4){0.f, 0.f, 0.f, 0.f};
        if (F.vcu < 2048) gla_pre_load(F, F.vcu, cur);
        nxt = cur;
        for (int u = F.vcu; u < 2048; u += F.G) { if (u + F.G < 2048) gla_pre_load(F, u + F.G, nxt); gla_pre_unit(F, u >> 7, (u >> 5) & 3, u & 31, cur); cur = nxt; }
    } SEAM(2);
    if (IN(3)) {
        const int nG = (F.G >= 128) ? 64 : (F.G / 2 > 0 ? F.G / 2 : 1);
        if (F.G == 1) { for (int u = 0; u < 64; ++u) gla_unit(F, u >> 2, u & 3); }
        if (F.G > 1 && F.vcu < nG) { for (int u = F.vcu; u < 64; u += nG) gla_unit(F, u >> 2, u & 3); }
        else { const int nS = F.G > 1 ? F.G - nG : 1, v0 = F.G > 1 ? F.vcu - nG : 0; for (int u = v0; u < 1024; u += nS) swa_unit(F, u >> 6, (u >> 2) & 15, u & 3);
            for (int r = v0 * NWAVES + F.wave; r < 2 * 16384; r += nS * NWAVES) { const int tb = r >= 16384, row = r & 16383;
                row_to_fp8(F.lane, F.in[tb ? 16 : 15] + (size_t)row * D, F.ws + (tb ? WS_V : WS_U) + (size_t)row * 128, (float*)(F.ws + (tb ? WS_SCLV : WS_SCLU)) + row); } }
    } SEAM(3);
    if (IN(4)) {
        for (int u = F.vcu; u < 2048; u += F.G) gla_post_unit(F, u >> 7, (u >> 5) & 3, u & 31);
    } SEAM(4);
    if (IN(5)) {
        { pg8::Gemm g{(const pg8::bf16_t*)F.out, (const pg8::bf16_t*)(F.ws + WS_WA), T, D, D}; pg8::StaticOrder S; S.init(T, D, F.G, (int)blockIdx.x);
          EpiB<1> E{F.ws}; pg8::gemm_phase<EpiB<1>, pg8::StaticOrder, true, true>(F.lds, g, S, E); }
        asm volatile("s_waitcnt vmcnt(0)" ::: "memory"); __syncthreads();
        { pg8::Gemm g{(const pg8::bf16_t*)F.out + (size_t)T * D, (const pg8::bf16_t*)(F.ws + WS_WB), T, D, D}; pg8::StaticOrder S; S.init(T, D, F.G, (int)blockIdx.x);
          EpiB<2> E{F.ws}; pg8::gemm_phase<EpiB<2>, pg8::StaticOrder, true, true>(F.lds, g, S, E); }
    } SEAM(5);
    if (IN(6)) {
        pg8::Gemm g{(const pg8::bf16_t*)(F.ws + WS_YA), (const pg8::bf16_t*)(F.ws + WS_WO), T, D, D}; pg8::StaticOrder S; S.init(T, D, F.G, (int)blockIdx.x);
        EpiX1 E{F.in[0], F.out}; pg8::gemm_phase<EpiX1, pg8::StaticOrder, true, true>(F.lds, g, S, E);
    } SEAM(6);
    if (IN(7)) {
        const int gw = F.vcu * NWAVES + F.wave, NGW = F.G * NWAVES;
        for (int m = gw; m < T; m += 2 * NGW) { const int m2 = m + NGW;
            const f32x4* xa = (const f32x4*)(F.out + (size_t)m * D) + F.lane; const f32x4* xb = (const f32x4*)(F.out + (size_t)(m2 < T ? m2 : m) * D) + F.lane; const f32x4* gr = (const f32x4*)F.in[12] + F.lane;
            f32x4 va[4], vb[4]; float sa = 0.f, sb = 0.f;
#pragma unroll
            for (int j = 0; j < 4; ++j) { va[j] = xa[64 * j]; vb[j] = xb[64 * j]; }
#pragma unroll
            for (int j = 0; j < 4; ++j) { sa += (va[j].x * va[j].x + va[j].y * va[j].y) + (va[j].z * va[j].z + va[j].w * va[j].w); sb += (vb[j].x * vb[j].x + vb[j].y * vb[j].y) + (vb[j].z * vb[j].z + vb[j].w * vb[j].w); }
            sa = wave_sum(sa); sb = wave_sum(sb);
            const float ra = 1.f / sqrtf(sa * (1.f / D) + EPS), rb = 1.f / sqrtf(sb * (1.f / D) + EPS);
            u64* oa = (u64*)((bf16*)(F.ws + WS_XN2) + (size_t)m * D) + F.lane; u64* ob = (u64*)((bf16*)(F.ws + WS_XN2) + (size_t)(m2 < T ? m2 : m) * D) + F.lane;
#pragma unroll
            for (int j = 0; j < 4; ++j) { const f32x4 gg = gr[64 * j];
                oa[64 * j] = (u64)pk2(va[j].x * ra * gg.x, va[j].y * ra * gg.y) | ((u64)pk2(va[j].z * ra * gg.z, va[j].w * ra * gg.w) << 32);
                if (m2 < T) ob[64 * j] = (u64)pk2(vb[j].x * rb * gg.x, vb[j].y * rb * gg.y) | ((u64)pk2(vb[j].z * rb * gg.z, vb[j].w * rb * gg.w) << 32); } }
    } SEAM(7);
    if (IN(8)) {
        pg8::Gemm g{(const pg8::bf16_t*)(F.ws + WS_XN2), (const pg8::bf16_t*)(F.ws + WS_WPQ), T, 2048, D}; pg8::StaticOrder S; S.init(T, 2048, F.G, (int)blockIdx.x);
        EpiB<3> E{F.ws}; pg8::gemm_phase<EpiB<3>, pg8::StaticOrder, true, true>(F.lds, g, S, E);
    } SEAM(8);
    if (IN(9)) { for (int u = F.vcu; u < 128 * 8; u += F.G) peer_topk_unit(F, u >> 3, u & 7); } SEAM(9);
    const bool sl8 = (F.G % 8) == 0; const int my_vs = (int)blockIdx.x & 7, my_w = ((int)blockIdx.x >> 3) * NWAVES + F.wave, n_w = (F.G >> 3) * NWAVES;
    if (IN(10)) {
        if (sl8) peer_u_slice(F, my_vs, my_w, n_w);
        else { for (int vs = 0; vs < 8; ++vs) peer_u_slice(F, vs, F.vcu * NWAVES + F.wave, F.G * NWAVES); }
    } SEAM(10);
    if (IN(11)) { const int gw = F.vcu * NWAVES + F.wave, NGW = F.G * NWAVES; for (int tok = gw; tok < T; tok += 2 * NGW) peer_w_token2(F, tok, tok + NGW < T ? tok + NGW : tok); } SEAM(11);
    if (IN(12)) {
        if (sl8) peer_v_slice(F, my_vs, my_w, n_w);
        else { for (int vs = 0; vs < 8; ++vs) peer_v_slice(F, vs, F.vcu * NWAVES + F.wave, F.G * NWAVES); }
    }
#undef IN
#undef SEAM
}

extern "C" void kernel_launch(void* const* d_in, const int* in_sizes, int n_in, void* d_out, int out_size, void* d_ws, size_t ws_size, hipStream_t stream) {
    static int grid = 0;
    if (grid == 0) {
        if (n_in != 17 || out_size != T * D || ws_size < WS_END) { fprintf(stderr, "kernel_launch: unexpected shapes (n_in %d out %d ws %zu)\n", n_in, out_size, ws_size); grid = -1; return; }
        int dev = 0, cus = 0, per_cu = 0;
        if (hipGetDevice(&dev) != hipSuccess || hipDeviceGetAttribute(&cus, hipDeviceAttributeMultiprocessorCount, dev) != hipSuccess) { grid = -1; return; }
        if (hipFuncSetAttribute((const void*)mega_fwd, hipFuncAttributeMaxDynamicSharedMemorySize, LDS_BYTES) != hipSuccess) { fprintf(stderr, "kernel_launch: hipFuncSetAttribute failed\n"); grid = -1; return; }
        if (hipOccupancyMaxActiveBlocksPerMultiprocessor(&per_cu, (const void*)mega_fwd, NTHR, LDS_BYTES) != hipSuccess || per_cu < 1) { fprintf(stderr, "kernel_launch: occupancy query gave %d\n", per_cu); per_cu = 1; }
        (void)hipGetLastError();
        grid = cus;
    }
    if (grid < 0) return;
    (void)hipMemsetAsync((char*)d_ws + WS_CTL, 0, CTL_ZERO_BYTES, stream);
    Args a{};
    for (int i = 0; i < 17; ++i) a.in[i] = (const float*)d_in[i];
    a.out = (float*)d_out; a.ws = (unsigned char*)d_ws;
#ifndef MK_SPLIT
    a.ph_lo = 0; a.ph_hi = N_PHASES;
    void* kargs[] = {&a};
    hipError_t e = hipLaunchCooperativeKernel((const void*)mega_fwd, dim3(grid), dim3(NTHR), kargs, LDS_BYTES, stream);
    if (e != hipSuccess) fprintf(stderr, "kernel_launch: cooperative launch failed: %s\n", hipGetErrorString(e));
#else
    const int seq[] = {PHSEQ};
    for (int p : seq) { a.ph_lo = p; a.ph_hi = p + 1; hipLaunchKernelGGL(mega_fwd, dim3(grid), dim3(NTHR), LDS_BYTES, stream, a); }
#endif
}
```
